# Optimizing an MI355X kernel written in HIP

```python
import jax, jax.numpy as jnp
from jax import lax
import numpy as np

D_MODEL = 2048
BATCH = 2
SEQ = 4096
DEPTH = 4

CHUNK = 64
EXPAND = 2
D_INNER = EXPAND * D_MODEL
HEAD_DIM = 128
N_HEADS = D_INNER // HEAD_DIM
N_LEFT_CHUNKS = 8
BAND = (N_LEFT_CHUNKS + 1) * CHUNK
REL_CLIP = 256
N_REL = 2 * REL_CLIP + 1
Q_BLOCK = 128
N_A_LAYERS = DEPTH // 2
N_B_LAYERS = DEPTH - N_A_LAYERS
EPS = 1e-6
NEG_INF = -1e30

kernel_name = "yoco_chunked_relbias_forgetting_attn"


def rms_norm(x, g):
    xf = x.astype(jnp.float32)
    y = xf * lax.rsqrt(jnp.mean(xf * xf, axis=-1, keepdims=True) + EPS)
    return (y * g.astype(jnp.float32)).astype(x.dtype)


def split_heads(t):
    return t.reshape(t.shape[0], t.shape[1], N_HEADS, HEAD_DIM)


def chunked_relbias_attention(q, k, v, rel_bias):
    b, s = q.shape[0], q.shape[1]
    n_chunks = s // CHUNK
    pad = N_LEFT_CHUNKS * CHUNK
    k_pad = jnp.pad(k, ((0, 0), (pad, 0), (0, 0), (0, 0)))
    v_pad = jnp.pad(v, ((0, 0), (pad, 0), (0, 0), (0, 0)))
    qi = jnp.arange(CHUNK)[:, None]
    kj = jnp.arange(BAND)[None, :]
    rel_idx = jnp.clip(pad + qi - kj, -REL_CLIP, REL_CLIP) + REL_CLIP
    bias = rel_bias.astype(jnp.float32)[:, rel_idx]
    scale = HEAD_DIM ** -0.5
    band_pos = jnp.arange(BAND)

    def one_chunk(c):
        start = c * CHUNK
        q_c = lax.dynamic_slice_in_dim(q, start, CHUNK, axis=1)
        k_c = lax.dynamic_slice_in_dim(k_pad, start, BAND, axis=1)
        v_c = lax.dynamic_slice_in_dim(v_pad, start, BAND, axis=1)
        sc = jnp.einsum('bqhd,bkhd->bhqk', q_c, k_c).astype(jnp.float32) * scale + bias
        valid = (start + band_pos) >= pad
        sc = jnp.where(valid[None, None, None, :], sc, NEG_INF)
        p = jax.nn.softmax(sc, axis=-1).astype(v.dtype)
        return jnp.einsum('bhqk,bkhd->bqhd', p, v_c)

    out = lax.map(one_chunk, jnp.arange(n_chunks))
    return jnp.moveaxis(out, 0, 1).reshape(b, s, N_HEADS, HEAD_DIM)


def forgetting_attention(q, k, v, cum_logf_h):
    s = q.shape[1]
    scale = HEAD_DIM ** -0.5
    outs = []
    for i in range(s // Q_BLOCK):
        q0 = i * Q_BLOCK
        end = q0 + Q_BLOCK
        q_b = q[:, q0:end]
        k_b = k[:, :end]
        v_b = v[:, :end]
        sc = jnp.einsum('bqhd,bkhd->bhqk', q_b, k_b).astype(jnp.float32) * scale
        decay = cum_logf_h[:, :, q0:end, None] - cum_logf_h[:, :, None, :end]
        causal = (q0 + jnp.arange(Q_BLOCK))[:, None] >= jnp.arange(end)[None, :]
        sc = jnp.where(causal[None, None], sc + decay, NEG_INF)
        p = jax.nn.softmax(sc, axis=-1).astype(v.dtype)
        outs.append(jnp.einsum('bhqk,bkhd->bqhd', p, v_b))
    return jnp.concatenate(outs, axis=1)


def setup_inputs(seed: int = 0) -> dict:
    key = jax.random.key(seed)
    ks = jax.random.split(key, 16)
    f32 = jnp.float32
    d_scale = D_MODEL ** -0.5
    out_scale = 0.5 * D_INNER ** -0.5
    x = jax.random.normal(ks[0], (BATCH, SEQ, D_MODEL), f32)
    a_norm = 1.0 + 0.02 * jax.random.normal(ks[1], (N_A_LAYERS, D_MODEL), f32)
    a_w_in = d_scale * jax.random.normal(ks[2], (N_A_LAYERS, D_MODEL, 4 * D_INNER), f32)
    a_rel_bias = 0.1 * jax.random.normal(ks[3], (N_A_LAYERS, N_HEADS, N_REL), f32)
    a_w_out = out_scale * jax.random.normal(ks[4], (N_A_LAYERS, D_INNER, D_MODEL), f32)
    kv_norm = 1.0 + 0.02 * jax.random.normal(ks[5], (D_MODEL,), f32)
    kv_w = d_scale * jax.random.normal(ks[6], (D_MODEL, 2 * D_INNER), f32)
    f_w = d_scale * jax.random.normal(ks[7], (D_MODEL, N_HEADS), f32)
    f_b = jnp.linspace(1.0, 5.0, N_HEADS, dtype=f32) + 0.1 * jax.random.normal(ks[8], (N_HEADS,), f32)
    b_norm = 1.0 + 0.02 * jax.random.normal(ks[9], (N_B_LAYERS, D_MODEL), f32)
    b_w_in = d_scale * jax.random.normal(ks[10], (N_B_LAYERS, D_MODEL, 2 * D_INNER), f32)
    b_w_out = out_scale * jax.random.normal(ks[11], (N_B_LAYERS, D_INNER, D_MODEL), f32)
    final_norm = 1.0 + 0.02 * jax.random.normal(ks[12], (D_MODEL,), f32)
    return {"x": x, "a_norm": a_norm, "a_w_in": a_w_in, "a_rel_bias": a_rel_bias,
            "a_w_out": a_w_out, "kv_norm": kv_norm, "kv_w": kv_w, "f_w": f_w,
            "f_b": f_b, "b_norm": b_norm, "b_w_in": b_w_in, "b_w_out": b_w_out,
            "final_norm": final_norm}


def reference(x, a_norm, a_w_in, a_rel_bias, a_w_out, kv_norm, kv_w, f_w, f_b,
              b_norm, b_w_in, b_w_out, final_norm):
    b, s, _ = x.shape
    k_sh = v_sh = cum_logf_h = None
    for layer in range(DEPTH):
        if layer < N_A_LAYERS:
            h = rms_norm(x, a_norm[layer])
            q, k, v, g = jnp.split(h @ a_w_in[layer], 4, axis=-1)
            o = chunked_relbias_attention(split_heads(q), split_heads(k), split_heads(v),
                                          a_rel_bias[layer]).reshape(b, s, D_INNER)
            x = x + (o * jax.nn.silu(g)) @ a_w_out[layer]
        else:
            if layer == N_A_LAYERS:
                h_kv = rms_norm(x, kv_norm)
                k_s, v_s = jnp.split(h_kv @ kv_w, 2, axis=-1)
                k_sh, v_sh = split_heads(k_s), split_heads(v_s)
                logf = jax.nn.log_sigmoid((h_kv @ f_w + f_b).astype(jnp.float32))
                cum_logf_h = jnp.transpose(jnp.cumsum(logf, axis=1), (0, 2, 1))
            lb = layer - N_A_LAYERS
            h = rms_norm(x, b_norm[lb])
            q, g = jnp.split(h @ b_w_in[lb], 2, axis=-1)
            o = forgetting_attention(split_heads(q), k_sh, v_sh, cum_logf_h).reshape(b, s, D_INNER)
            x = x + (o * jax.nn.silu(g)) @ b_w_out[lb]
    return rms_norm(x, final_norm)
```

```cpp
#include <hip/hip_runtime.h>
#include <hip/hip_bf16.h>
#include <hip/hip_cooperative_groups.h>
#include <cstdio>
#include <cstdint>
namespace cg = cooperative_groups;
__device__ __forceinline__ int otid() { int t = threadIdx.x; asm volatile("" : "+v"(t)); return t; }
namespace pg8 {
#define PG8_LAS __attribute__((address_space(3)))
typedef unsigned short bf16_t;
typedef short bf16x8 __attribute__((ext_vector_type(8)));
typedef float f32x4 __attribute__((ext_vector_type(4)));
typedef unsigned u32x4 __attribute__((ext_vector_type(4)));
constexpr int BM = 256, BK = 64, HALF = 128, HTB = HALF * BK * 2  , STAGE_BYTES = 8 * HTB, NXCD = 8, WGM = 8;

__host__ __device__ __forceinline__ int lds_byte(int r, int c) { const int st = (r >> 4) * 2 + (c >> 5), rr = r & 15, cc = c & 31, ob = rr * 64 + cc * 2; return st * 1024 + (ob ^ (((ob >> 9) & 1) << 5)); }
__host__ __device__ __forceinline__ void stage_rc(int b, int& R, int& C) { const int st = b / 1024, sb = b % 1024, swz = sb ^ (((sb >> 9) & 1) << 5); R = (st >> 1) * 16 + swz / 64; C = (st & 1) * 32 + (swz % 64) / 2; }
__host__ __device__ __forceinline__ int perm32(int rho) { const int n = rho >> 4, i = rho & 15; return 8 * (i >> 2) + 4 * n + (i & 3); }

struct Unit { int pm, pn; };
struct Gemm { const bf16_t* A; const bf16_t* Bt; int M, N, K; };

struct StaticOrder {
    int nM, nN, nwg, G, c;
    __host__ __device__ void init(int M, int N, int G_, int c_) { nM = M / BM; nN = N / BM; nwg = nM * nN; G = G_; c = c_; }
    __host__ __device__ bool next(int i, Unit& u) const {
        const long L = (long)i * G + c; if (L >= nwg) return false;
        int wgid = (int)L; { const int q = nwg / NXCD, r = nwg % NXCD, xcd = wgid % NXCD, off = wgid / NXCD; wgid = (xcd < r ? xcd * (q + 1) : r * (q + 1) + (xcd - r) * q) + off; }
        const int nig = WGM * nN, gid = wgid / nig, fm = gid * WGM, gsz = (nM - fm) < WGM ? (nM - fm) : WGM;
        u.pm = fm + ((wgid % nig) % gsz); u.pn = (wgid % nig) / gsz; return true;
    }
    __device__ __forceinline__ void a_ready(const Unit&) const {}
    __device__ __forceinline__ void done(const Unit&) const {}
};
__device__ __forceinline__ unsigned cvt_pk_bf16(float lo, float hi) { unsigned r; asm volatile("v_cvt_pk_bf16_f32 %0, %1, %2" : "=v"(r) : "v"(lo), "v"(hi)); return r; }
typedef float f32x2 __attribute__((ext_vector_type(2)));
struct EpiBf16 {
    static constexpr bool PERM = true, AFTER_DRAIN = false;
    bf16_t* O; int coff;
    __device__ __forceinline__ void operator()(const f32x4 (&acc)[2][2][4][2], const Unit& u, int wr, int wc, int fr, int fq) const {
        const int row0 = u.pm * BM + wr * 64 + fr, b = row0 >> 12, s0 = row0 & 4095;
#pragma unroll
        for (int bj = 0; bj < 2; ++bj) { const int c = coff + u.pn * BM + bj * HALF + wc * 32 + 8 * fq;
            bf16_t* base = O + ((size_t)((((c >> 12) * 2 + b) * 32 + ((c >> 7) & 31))) * 4096 + s0) * 128 + (c & 127);
#pragma unroll
            for (int ai = 0; ai < 2; ++ai)
#pragma unroll
                for (int m = 0; m < 4; ++m) { const f32x4 v0 = acc[ai][bj][m][0], v1 = acc[ai][bj][m][1];
                    u32x4 w; w.x = cvt_pk_bf16(v0[0], v0[1]); w.y = cvt_pk_bf16(v0[2], v0[3]); w.z = cvt_pk_bf16(v1[0], v1[1]); w.w = cvt_pk_bf16(v1[2], v1[3]);
                    *(__attribute__((address_space(1))) u32x4*)(base + (size_t)(ai * HALF + m * 16) * 128) = w; } }
    }
};
struct EpiRes {
    static constexpr bool PERM = false, AFTER_DRAIN = false;
    const float* res; float* out; int ldc;
    __device__ __forceinline__ void operator()(const f32x4 (&acc)[2][2][4][2], const Unit& u, int wr, int wc, int fr, int fq) const {
        const int row0 = u.pm * BM + wr * 64 + fr, col0 = u.pn * BM + wc * 32 + 4 * fq;
#pragma unroll
        for (int ai = 0; ai < 2; ++ai)
#pragma unroll
            for (int m = 0; m < 4; ++m) { const size_t off = (size_t)(row0 + ai * HALF + m * 16) * ldc + col0;
#pragma unroll
                for (int bj = 0; bj < 2; ++bj)
#pragma unroll
                    for (int n = 0; n < 2; ++n) { const size_t o = off + bj * HALF + n * 16; const f32x4 r = *(const __attribute__((address_space(1))) f32x4*)(res + o); *(__attribute__((address_space(1))) f32x4*)(out + o) = r + acc[ai][bj][m][n]; } }
    }
};
template <class Epi, class Sched, bool ALIGN_EPI = false, bool SP2 = false>
__device__ __forceinline__ void gemm_phase(PG8_LAS unsigned char* lds, const Gemm g, const Sched& S, const Epi& E) {
    const int tid = otid(), wid = __builtin_amdgcn_readfirstlane(tid >> 6), lane = tid & 63, wr = wid >> 2, wc = wid & 3, fr = lane & 15, fq = lane >> 4;
    const int K = g.K, nt = K / BK;
    unsigned voffA[2], voffB[2];
#pragma unroll
    for (int i = 0; i < 2; ++i) { int R, C; stage_rc(tid * 16 + i * 8192, R, C); const int Rb = Epi::PERM ? ((R & ~31) + perm32(R & 31)) : R;
        voffA[i] = (unsigned)(R * K + C) * 2u; voffB[i] = (unsigned)(Rb * K + C) * 2u; }
    const size_t kstep = (size_t)(BK * 2);
    const size_t hstep = (size_t)HALF * K * 2;
    const size_t tstep = 2 * hstep;
    const unsigned ldsw = (unsigned)wid * 1024u;
    const int aoff = lds_byte(wr * 64 + fr, fq * 8), boff = lds_byte(wc * 32 + fr, fq * 8);
#define PG8_SA(b, h) (((b) * 2 + (h)) * HTB)
#define PG8_SB(b, h) ((4 + (b) * 2 + (h)) * HTB)
#define PG8_STAGE(bufoff, gbase, voff) do { _Pragma("unroll") for (int _i = 0; _i < 2; ++_i) \
        __builtin_amdgcn_global_load_lds((const unsigned*)((const char*)(gbase) + (voff)[_i]), (PG8_LAS unsigned*)(lds + (bufoff) + ldsw + _i * 8192), 16, 0, 0); } while (0)
#define PG8_LDA(dst, b, h) do { _Pragma("unroll") for (int m = 0; m < 4; ++m) _Pragma("unroll") for (int k = 0; k < 2; ++k) dst[m][k] = *(const PG8_LAS bf16x8*)(lds + PG8_SA(b, h) + aoff + m * 2048 + k * 1024); } while (0)
#define PG8_LDB(dst, b, h) do { _Pragma("unroll") for (int n = 0; n < 2; ++n) _Pragma("unroll") for (int k = 0; k < 2; ++k) dst[n][k] = *(const PG8_LAS bf16x8*)(lds + PG8_SB(b, h) + boff + n * 2048 + k * 1024); } while (0)
#define PG8_MMA(ai, bj, At, Bt) do { __builtin_amdgcn_s_setprio(1); _Pragma("unroll") for (int m = 0; m < 4; ++m) _Pragma("unroll") for (int n = 0; n < 2; ++n) _Pragma("unroll") for (int k = 0; k < 2; ++k) \
        acc[ai][bj][m][n] = __builtin_amdgcn_mfma_f32_16x16x32_bf16(Bt[n][k], At[m][k], acc[ai][bj][m][n], 0, 0, 0); __builtin_amdgcn_s_setprio(0); } while (0)
#define PG8_WAIT_V(n) asm volatile("s_waitcnt vmcnt(" #n ")" ::: "memory")
#define PG8_WAIT_L(n) asm volatile("s_waitcnt lgkmcnt(" #n ")" ::: "memory")
#define PG8_BAR __builtin_amdgcn_s_barrier()
#define PG8_SCHED __builtin_amdgcn_sched_barrier(0)
    Unit cur, nxt; int ui = 0;
    if (!S.next(0, cur)) return;
    f32x4 acc[2][2][4][2];
#pragma unroll
    for (int a = 0; a < 2; ++a)
#pragma unroll
        for (int b = 0; b < 2; ++b)
#pragma unroll
            for (int m = 0; m < 4; ++m)
#pragma unroll
                for (int n = 0; n < 2; ++n) acc[a][b][m][n] = (f32x4){0.f, 0.f, 0.f, 0.f};
    bf16x8 At[4][2], B0[2][2], B1[2][2];
    const char* cA = (const char*)g.A + (size_t)cur.pm * tstep; const char* cB = (const char*)g.Bt + (size_t)cur.pn * tstep;
    S.a_ready(cur);
    if constexpr (SP2) {
        PG8_STAGE(PG8_SB(0, 0), cB, voffB); PG8_STAGE(PG8_SB(0, 1), cB + hstep, voffB); PG8_STAGE(PG8_SA(0, 0), cA, voffA); PG8_STAGE(PG8_SA(0, 1), cA + hstep, voffA);
        if (wr == 1) PG8_BAR;
        PG8_WAIT_V(2); PG8_BAR;
        PG8_STAGE(PG8_SB(1, 0), cB + kstep, voffB); PG8_STAGE(PG8_SA(1, 0), cA + kstep, voffA); PG8_STAGE(PG8_SB(1, 1), cB + hstep + kstep, voffB);
        PG8_WAIT_V(6); PG8_BAR;
    } else {
        PG8_STAGE(PG8_SB(0, 0), cB, voffB); PG8_STAGE(PG8_SA(0, 0), cA, voffA); PG8_STAGE(PG8_SB(0, 1), cB + hstep, voffB); PG8_STAGE(PG8_SA(0, 1), cA + hstep, voffA);
        if (wr == 1) PG8_BAR;
        PG8_WAIT_V(4); PG8_BAR;
        PG8_STAGE(PG8_SB(1, 0), cB + kstep, voffB); PG8_STAGE(PG8_SA(1, 0), cA + kstep, voffA); PG8_STAGE(PG8_SB(1, 1), cB + hstep + kstep, voffB);
        PG8_WAIT_V(6); PG8_BAR;
    }
    for (;;) {
        const bool has_next = S.next(ui + 1, nxt);
        const char* nA = has_next ? (const char*)g.A + (size_t)nxt.pm * tstep : cA; const char* nB = has_next ? (const char*)g.Bt + (size_t)nxt.pn * tstep : cB;
        for (int t = 0; t < nt; t += 2) {
            const bool last = (t == nt - 2);
            const char* a1 = cA + (size_t)(t + 1) * kstep;
            const char* a2 = last ? nA : cA + (size_t)(t + 2) * kstep; const char* b2 = last ? nB : cB + (size_t)(t + 2) * kstep;
            const char* a3 = a2 + kstep; const char* b3 = b2 + kstep;
            if (last && has_next) S.a_ready(nxt);
            if constexpr (SP2) {
            PG8_LDB(B0, 0, 0); PG8_LDB(B1, 0, 1); PG8_SCHED; PG8_LDA(At, 0, 0); PG8_STAGE(PG8_SA(1, 1), a1 + hstep, voffA);
            PG8_WAIT_V(8); PG8_WAIT_L(0); PG8_BAR; PG8_MMA(0, 0, At, B0); PG8_MMA(0, 1, At, B1); PG8_BAR; PG8_SCHED;
            PG8_LDA(At, 0, 1); PG8_STAGE(PG8_SB(0, 0), b2, voffB); PG8_STAGE(PG8_SB(0, 1), b2 + hstep, voffB); PG8_STAGE(PG8_SA(0, 0), a2, voffA);
            PG8_WAIT_V(8); PG8_WAIT_L(0); PG8_BAR; PG8_MMA(1, 0, At, B0); PG8_MMA(1, 1, At, B1); PG8_BAR; PG8_SCHED;
            PG8_LDB(B0, 1, 0); PG8_LDB(B1, 1, 1); PG8_SCHED; PG8_LDA(At, 1, 0); PG8_STAGE(PG8_SA(0, 1), a2 + hstep, voffA);
            PG8_WAIT_V(8); PG8_WAIT_L(0); PG8_BAR; PG8_MMA(0, 0, At, B0); PG8_MMA(0, 1, At, B1); PG8_BAR; PG8_SCHED;
            PG8_LDA(At, 1, 1); PG8_STAGE(PG8_SB(1, 0), b3, voffB); PG8_STAGE(PG8_SB(1, 1), b3 + hstep, voffB); PG8_STAGE(PG8_SA(1, 0), a3, voffA);
            PG8_WAIT_V(8); PG8_WAIT_L(0); PG8_BAR; PG8_MMA(1, 0, At, B0); PG8_MMA(1, 1, At, B1); PG8_BAR; PG8_SCHED;
            } else {
            PG8_LDB(B0, 0, 0); PG8_SCHED; PG8_LDA(At, 0, 0); PG8_STAGE(PG8_SA(1, 1), a1 + hstep, voffA);
            PG8_WAIT_L(8); PG8_BAR; PG8_WAIT_L(0); PG8_MMA(0, 0, At, B0); PG8_BAR; PG8_SCHED;
            PG8_LDB(B1, 0, 1); PG8_STAGE(PG8_SB(0, 0), b2, voffB);
            PG8_BAR; PG8_WAIT_L(0); PG8_MMA(0, 1, At, B1); PG8_BAR;
            PG8_LDA(At, 0, 1); PG8_STAGE(PG8_SA(0, 0), a2, voffA);
            PG8_BAR; PG8_WAIT_L(0); PG8_MMA(1, 0, At, B0); PG8_BAR; PG8_SCHED;
            PG8_STAGE(PG8_SB(0, 1), b2 + hstep, voffB);
            PG8_WAIT_V(6); PG8_BAR; PG8_MMA(1, 1, At, B1); PG8_BAR;
            PG8_LDB(B0, 1, 0); PG8_SCHED; PG8_LDA(At, 1, 0); PG8_STAGE(PG8_SA(0, 1), a2 + hstep, voffA);
            PG8_WAIT_L(8); PG8_BAR; PG8_WAIT_L(0); PG8_MMA(0, 0, At, B0); PG8_BAR; PG8_SCHED;
            PG8_LDB(B1, 1, 1); PG8_STAGE(PG8_SB(1, 0), b3, voffB);
            PG8_BAR; PG8_WAIT_L(0); PG8_MMA(0, 1, At, B1); PG8_BAR;
            PG8_LDA(At, 1, 1); PG8_STAGE(PG8_SA(1, 0), a3, voffA);
            PG8_BAR; PG8_WAIT_L(0); PG8_MMA(1, 0, At, B0); PG8_BAR; PG8_SCHED;
            PG8_STAGE(PG8_SB(1, 1), b3 + hstep, voffB);
            PG8_WAIT_V(6); PG8_BAR; PG8_MMA(1, 1, At, B1); PG8_BAR;
            }
        }
        if constexpr (ALIGN_EPI) { if (wr == 0) PG8_BAR; }
        if constexpr (!Epi::AFTER_DRAIN) { E(acc, cur, wr, wc, fr, fq); S.done(cur); }
        if (!has_next) break;
#pragma unroll
        for (int a = 0; a < 2; ++a)
#pragma unroll
            for (int b = 0; b < 2; ++b)
#pragma unroll
                for (int m = 0; m < 4; ++m)
#pragma unroll
                    for (int n = 0; n < 2; ++n) acc[a][b][m][n] = (f32x4){0.f, 0.f, 0.f, 0.f};
        cur = nxt; cA = nA; cB = nB; ++ui;
        if constexpr (ALIGN_EPI) { if (wr == 1) PG8_BAR; }
    }
    PG8_WAIT_V(0);
    if constexpr (!ALIGN_EPI) { if (wr == 0) PG8_BAR; }
    PG8_BAR;
    if constexpr (Epi::AFTER_DRAIN) { E.fused(acc, cur, wr, wc, fr, fq, lds, wid, lane); S.done(cur); }
#undef PG8_SA
#undef PG8_SB
#undef PG8_STAGE
#undef PG8_LDA
#undef PG8_LDB
#undef PG8_MMA
#undef PG8_WAIT_V
#undef PG8_WAIT_L
#undef PG8_BAR
#undef PG8_SCHED
}
}
#ifndef PG8_SP2
#define PG8_SP2 true
#endif
#ifndef PG8_ALIGN
#define PG8_ALIGN true
#endif
namespace att {
using bf16 = __hip_bfloat16;
typedef short bf16x8 __attribute__((ext_vector_type(8)));
typedef short s16x4 __attribute__((ext_vector_type(4)));
typedef float f32x16 __attribute__((ext_vector_type(16)));
typedef float f32x4 __attribute__((ext_vector_type(4)));
typedef unsigned u32x4 __attribute__((ext_vector_type(4)));
constexpr int D = 128, SEQ = 4096, NH = 32;
constexpr int LD = 128;
constexpr int LDO = 4096;
constexpr float SCALE = 0.08838834764831845f, INV_SCALE = 11.313708498984761f;
constexpr float THR = 8.f;
#ifndef ATT_ACP
#define ATT_ACP 1
#endif
constexpr float ACP_MARGIN = 30.f;
#ifndef ATT_SKIP
#define ATT_SKIP true
#endif
#ifndef ATT_SKIP_PV
#define ATT_SKIP_PV false
#endif
constexpr int NW = 8, QBLK = 32, KVBLK = 64, QB = NW * QBLK;
constexpr int SHM_V = KVBLK * D * 2, SHM_K = KVBLK * D * 2;
constexpr int WS_OFF = 2 * SHM_V + 2 * SHM_K, TBL_OFF = WS_OFF + NW * 64 * 4, OST_OFF = TBL_OFF + SEQ * 4, LDS_BYTES = OST_OFF + NW * QBLK * D * 2;
constexpr int NLEFT = 8, RELC = 256, NREL = 513, TOFF = NLEFT * 64 + 63, TPAD = 256, TLEN = TOFF + 64 + 2 * TPAD, TBASE = TOFF + TPAD - 64;

#define KSWZ(row, colB) ((row) * 256 + ((colB) ^ (((row) & 7) << 4)))
#define SBAR() __builtin_amdgcn_sched_barrier(0)
__device__ __forceinline__ int v_st(int k, int c) { const int kk = (k & ~0xC) | ((k & 4) << 1) | ((k & 8) >> 1); return ((kk >> 3) * 4 + (c >> 5)) * 512 + ((kk & 7) * 32 + (c & 31)) * 2; }
__device__ __forceinline__ int v_rd_base(int lane) { return ((lane & 3) << 3) | (((lane >> 2) & 3) << 6) | (((lane >> 4) & 1) << 5) | (((lane >> 5) & 1) << 8); }
constexpr int v_rd_off(int d0, int ks, int half) { return d0 * 512 + ks * 4096 + half * 2048; }
__device__ __forceinline__ int crow(int r, int hi) { return (r & 3) + 8 * (r >> 2) + 4 * hi; }
__device__ __forceinline__ unsigned cvtpk(float lo, float hi) { unsigned r; asm volatile("v_cvt_pk_bf16_f32 %0, %1, %2" : "=v"(r) : "v"(lo), "v"(hi)); return r; }
#define AGAS __attribute__((address_space(1)))
__device__ __forceinline__ bf16x8 load8(const bf16* p) { return *(const AGAS bf16x8*)p; }
__device__ __forceinline__ void mask_tile(f32x16& p0, f32x16& p1, int dq, unsigned W) {
    const float NEG = -__builtin_inff();
#pragma unroll
    for (int r = 0; r < 16; ++r) {
        const int c = (r & 3) + 8 * (r >> 2);
        if ((unsigned)(dq - c) >= W) p0[r] = NEG;
        if ((unsigned)(dq - c - 32) >= W) p1[r] = NEG;
    }
}
__device__ __forceinline__ void partialSM(f32x16& p0, f32x16& p1, float& m_reg, float& mn, float& alpha) {
    float pmax = p0[0]; for (int r = 1; r < 16; ++r) pmax = fmaxf(pmax, p0[r]); for (int r = 0; r < 16; ++r) pmax = fmaxf(pmax, p1[r]);
    { auto rr = __builtin_amdgcn_permlane32_swap(__float_as_uint(pmax), __float_as_uint(pmax), false, false);
      pmax = fmaxf(__uint_as_float(rr[0]), __uint_as_float(rr[1])); }
    constexpr float C2 = 1.4426950408889634f * SCALE;
    if (__builtin_expect(__all((pmax - m_reg) * SCALE <= THR), 1)) { mn = m_reg; alpha = 1.f; }
    else { mn = fmaxf(m_reg, pmax); alpha = __builtin_amdgcn_exp2f((m_reg - mn) * C2); m_reg = mn; }
    const float mnL = -mn * C2;
    { typedef float f32x2p __attribute__((ext_vector_type(2)));
      float c2r = C2; asm volatile("" : "+v"(c2r)); const f32x2p cv = {c2r, c2r}, mv = {mnL, mnL};
#pragma unroll
      for (int r = 0; r < 16; r += 2) { f32x2p a = {p0[r], p0[r + 1]}, b = {p1[r], p1[r + 1]};
          a = __builtin_elementwise_fma(a, cv, mv); b = __builtin_elementwise_fma(b, cv, mv); p0[r] = a.x; p0[r + 1] = a.y; p1[r] = b.x; p1[r + 1] = b.y; } }
    for (int r = 0; r < 16; ++r) p0[r] = __builtin_amdgcn_exp2f(p0[r]);
}
__device__ __forceinline__ void finishSM(f32x16& p0, f32x16& p1, float alpha, float& l_reg, bf16x8& pa0, bf16x8& pa1, bf16x8& pa2, bf16x8& pa3) {
    for (int r = 0; r < 16; ++r) p1[r] = __builtin_amdgcn_exp2f(p1[r]);
    float ps; { typedef float f32x2p __attribute__((ext_vector_type(2)));
      f32x2p s0 = {p0[0], p0[1]}, s1 = {p1[0], p1[1]};
#pragma unroll
      for (int r = 2; r < 16; r += 2) { s0 += (f32x2p){p0[r], p0[r + 1]}; s1 += (f32x2p){p1[r], p1[r + 1]}; }
      s0 += s1; ps = s0.x + s0.y; }
    { auto rr = __builtin_amdgcn_permlane32_swap(__float_as_uint(ps), __float_as_uint(ps), false, false);
      ps = __uint_as_float(rr[0]) + __uint_as_float(rr[1]); }
    l_reg = l_reg * alpha + ps;
#define PK4(P, B_, OUT) do { unsigned a0 = cvtpk(P[B_+0], P[B_+1]), a1 = cvtpk(P[B_+2], P[B_+3]);                          \
        unsigned b0 = cvtpk(P[B_+4], P[B_+5]), b1 = cvtpk(P[B_+6], P[B_+7]);                                             \
        auto r0 = __builtin_amdgcn_permlane32_swap(a0, b0, false, false); auto r1 = __builtin_amdgcn_permlane32_swap(a1, b1, false, false); \
        u32x4 w = {r0[0], r1[0], r0[1], r1[1]}; OUT = *reinterpret_cast<bf16x8*>(&w); } while (0)
    PK4(p0, 0, pa0); PK4(p0, 8, pa1); PK4(p1, 0, pa2); PK4(p1, 8, pa3);
#undef PK4
}
template <int KB, bool SK, bool AL16>
__device__ __forceinline__ void qkt(f32x16& p0, f32x16& p1, const char* K_lds, int r32, int hi, const bf16x8* qr, bool act, const float* tb) {
    if (SK && !act) { const float NEG = -__builtin_inff();
#pragma unroll
        for (int r = 0; r < 16; ++r) { p0[r] = NEG; p1[r] = NEG; } return; }
    if (AL16) {
#pragma unroll
        for (int q = 0; q < 4; ++q) { const f32x4 a = *(const f32x4*)(tb + 8 * q), b = *(const f32x4*)(tb + 32 + 8 * q);
#pragma unroll
            for (int e = 0; e < 4; ++e) { p0[4 * q + e] = a[e]; p1[4 * q + e] = b[e]; } }
    } else {
#pragma unroll
        for (int r = 0; r < 16; ++r) { p0[r] = tb[(r & 3) + 8 * (r >> 2)]; p1[r] = tb[32 + (r & 3) + 8 * (r >> 2)]; }
    }
    const char* kb[4];
#pragma unroll
    for (int dd = 0; dd < 4; ++dd) kb[dd] = K_lds + KB * SHM_K + KSWZ(r32, (dd * 16 + hi * 8) * 2);
#pragma unroll
    for (int d0 = 0; d0 < 8; ++d0) { const char* a = kb[d0 & 3] + (d0 >> 2) * 128;
        bf16x8 b0 = *reinterpret_cast<const bf16x8*>(a);
        bf16x8 b1 = *reinterpret_cast<const bf16x8*>(a + 32 * 256);
        p0 = __builtin_amdgcn_mfma_f32_32x32x16_bf16(b0, qr[d0], p0, 0, 0, 0);
        p1 = __builtin_amdgcn_mfma_f32_32x32x16_bf16(b1, qr[d0], p1, 0, 0, 0); }
}
template <int VB, bool SK>
__device__ __forceinline__ void pv_tile(f32x16* o, int vb0, bf16x8 pa0, bf16x8 pa1, bf16x8 pa2, bf16x8 pa3, bool act) {
    if (SK && !act) return;
#define TRRD(dst, off) asm volatile("ds_read_b64_tr_b16 %0, %1 offset:%2" : "=&v"(dst) : "v"(vb0), "i"(off) : "memory")
#define PV_D0(d0) do { s16x4 l0, l1, l2, l3, h0, h1, h2, h3; constexpr int b_ = VB * SHM_V + v_rd_off(d0, 0, 0); \
        TRRD(l0, b_); TRRD(h0, b_ + 2048); TRRD(l1, b_ + 4096); TRRD(h1, b_ + 6144); TRRD(l2, b_ + 8192); TRRD(h2, b_ + 10240); TRRD(l3, b_ + 12288); TRRD(h3, b_ + 14336); \
        asm volatile("s_waitcnt lgkmcnt(0)" ::: "memory"); SBAR();   \
        o[d0] = __builtin_amdgcn_mfma_f32_32x32x16_bf16(pa0, (bf16x8){l0[0], l0[1], l0[2], l0[3], h0[0], h0[1], h0[2], h0[3]}, o[d0], 0, 0, 0);   \
        o[d0] = __builtin_amdgcn_mfma_f32_32x32x16_bf16(pa1, (bf16x8){l1[0], l1[1], l1[2], l1[3], h1[0], h1[1], h1[2], h1[3]}, o[d0], 0, 0, 0);   \
        o[d0] = __builtin_amdgcn_mfma_f32_32x32x16_bf16(pa2, (bf16x8){l2[0], l2[1], l2[2], l2[3], h2[0], h2[1], h2[2], h2[3]}, o[d0], 0, 0, 0);   \
        o[d0] = __builtin_amdgcn_mfma_f32_32x32x16_bf16(pa3, (bf16x8){l3[0], l3[1], l3[2], l3[3], h3[0], h3[1], h3[2], h3[3]}, o[d0], 0, 0, 0); } while (0)
    PV_D0(0); PV_D0(1); PV_D0(2); PV_D0(3);
#undef PV_D0
#undef TRRD
}
struct BlockRef { const bf16* Q; const bf16* K; const bf16* V; const bf16* G; bf16* O; const float* tsrc; const float* kn; int P0; };
struct Seam { bf16x8 qr[8]; bf16x8 st_v0, st_v1, st_k0, st_k1; };
template <int MODE> __device__ __forceinline__ int blk_jlo(int P0) { if (MODE == 0) { const int j = P0 / KVBLK - NLEFT; return j > 0 ? j : 0; } return 0; }
#ifndef ATT_REVERSE
#define ATT_REVERSE true
#endif
template <int MODE> __device__ __forceinline__ int blk_first(int P0) { return (MODE == 1 && ATT_REVERSE) ? (P0 / KVBLK + QB / KVBLK - 1) * KVBLK : blk_jlo<MODE>(P0) * KVBLK; }
template <int MODE> __device__ __forceinline__ void build_table(float* tbl, const BlockRef& r, int tid) {
    if (MODE == 0) {
        for (int i = tid; i < 4 * 1024; i += NW * 64) { const int a = i >> 10, x = i & 1023; int d = TBASE - (x + a); d = d < -RELC ? -RELC : (d > RELC ? RELC : d); tbl[i] = ((const AGAS float*)r.tsrc)[d + RELC] * INV_SCALE; }
    } else {
        const float c0 = ((const AGAS float*)r.tsrc)[r.P0]; const int n = r.P0 + QB;
        for (int s = tid * 4; s < n; s += NW * 64 * 4) { const f32x4 v = *(const AGAS f32x4*)(r.tsrc + s); *(f32x4*)(tbl + s) = (c0 - v) * INV_SCALE; }
    }
}
#define ROW(p, k0, rr) ((p) + (size_t)((k0) + (rr)) * LD + sc)
#define VMW() asm volatile("s_waitcnt vmcnt(0)" ::: "memory")
#define VMWN(n) asm volatile("s_waitcnt vmcnt(%0)" :: "i"(n) : "memory")
#define SLOAD_H(Kp, Vp, k0) do { S.st_v0 = load8(ROW(Vp, k0, sr)); S.st_v1 = load8(ROW(Vp, k0, 32 + sr));              \
                         S.st_k0 = load8(ROW(Kp, k0, sr)); S.st_k1 = load8(ROW(Kp, k0, 32 + sr)); } while (0)
#define SLOAD_K(Kp, k0) do { S.st_k0 = load8(ROW(Kp, k0, sr)); S.st_k1 = load8(ROW(Kp, k0, 32 + sr)); } while (0)
#define SLOAD_V(Vp, k0) do { S.st_v0 = load8(ROW(Vp, k0, sr)); S.st_v1 = load8(ROW(Vp, k0, 32 + sr)); } while (0)
#define SWRITE_HK(bf) do { *(bf16x8*)(K_lds + (bf) * SHM_K + kws) = S.st_k0; *(bf16x8*)(K_lds + (bf) * SHM_K + kws + 32 * 256) = S.st_k1; } while (0)
#define SWRITE_HV(bf) do { *(bf16x8*)(V_lds + (bf) * SHM_V + vst0) = S.st_v0; *(bf16x8*)(V_lds + (bf) * SHM_V + vst1) = S.st_v1; } while (0)
#define SWRITE_H(bf) do { SWRITE_HV(bf); SWRITE_HK(bf); } while (0)
template <int MODE>
__device__ __forceinline__ void attn_prime(const BlockRef& cur, char* lds, Seam& S) {
    const int tid = otid(), wid = __builtin_amdgcn_readfirstlane(tid >> 6), lane = tid & 63, r32 = lane & 31, hi = lane >> 5;
    const int sr = tid >> 4, sc = (tid & 15) * 8, kws = KSWZ(sr, sc * 2); char* K_lds = lds + 2 * SHM_V;
    const int kb0 = blk_first<MODE>(cur.P0);
    for (int d0 = 0; d0 < 8; ++d0) S.qr[d0] = load8(cur.Q + (size_t)(wid * QBLK + r32) * LD + d0 * 16 + hi * 8);
    SLOAD_H(cur.K, cur.V, kb0);
    build_table<MODE>((float*)(lds + TBL_OFF), cur, tid);
    VMW(); SWRITE_HK(0);
    __syncthreads();
}
#define KBASE_REV(t) ((j_hi - 1 - (t)) * KVBLK)
template <int MODE>
__device__ __forceinline__ void attn_block(const BlockRef& cur, const BlockRef& nxt, char* lds, Seam& S, unsigned* qctr = nullptr, volatile unsigned* qslot = nullptr, int qhome = 0) {
    constexpr bool SK = (MODE == 0) && ATT_SKIP; constexpr bool SKP = (MODE == 0) && ATT_SKIP_PV;
    const int tid = otid(), wid = __builtin_amdgcn_readfirstlane(tid >> 6), lane = tid & 63, r32 = lane & 31, hi = lane >> 5;
    const int j_lo = blk_jlo<MODE>(cur.P0);
    const int j_hi = cur.P0 / KVBLK + QB / KVBLK;
    int NT = j_hi - j_lo;
    const int kbn = blk_first<MODE>(nxt.P0);
    const int qlo = cur.P0 + wid * QBLK, qm = qlo + r32 - 4 * hi;
    char* V_lds = lds; char* K_lds = lds + 2 * SHM_V;
    float* ws = (float*)(lds + WS_OFF) + wid * 64; float* li_l = ws, * al_l = ws + 32;
    float* tbl = (float*)(lds + TBL_OFF);
    if (MODE == 1 && ATT_ACP && ATT_REVERSE) {
        const float kn2 = *(const AGAS float*)cur.kn;
        float s2 = 0.f, dq = 0.f;
        { const bf16* krow = cur.K + (size_t)(qlo + r32) * LD + hi * 8;
#pragma unroll
          for (int d0 = 0; d0 < 8; ++d0) { const bf16x8 kk = load8(krow + d0 * 16);
#pragma unroll
              for (int e = 0; e < 8; ++e) { const float v = __uint_as_float((unsigned)(unsigned short)S.qr[d0][e] << 16), w = __uint_as_float((unsigned)(unsigned short)kk[e] << 16); s2 = fmaf(v, v, s2); dq = fmaf(v, w, dq); } } }
        { auto rr = __builtin_amdgcn_permlane32_swap(__float_as_uint(s2), __float_as_uint(s2), false, false); s2 = __uint_as_float(rr[0]) + __uint_as_float(rr[1]); }
        { auto rr = __builtin_amdgcn_permlane32_swap(__float_as_uint(dq), __float_as_uint(dq), false, false); dq = __uint_as_float(rr[0]) + __uint_as_float(rr[1]); }
#define SWZ_MAX(x, o) x = fmaxf(x, __int_as_float(__builtin_amdgcn_ds_swizzle(__float_as_int(x), 0x1f | ((o) << 10))))
#define SWZ_MIN(x, o) x = fminf(x, __int_as_float(__builtin_amdgcn_ds_swizzle(__float_as_int(x), 0x1f | ((o) << 10))))
        SWZ_MAX(s2, 1); SWZ_MAX(s2, 2); SWZ_MAX(s2, 4); SWZ_MAX(s2, 8); SWZ_MAX(s2, 16);
        SWZ_MIN(dq, 1); SWZ_MIN(dq, 2); SWZ_MIN(dq, 4); SWZ_MIN(dq, 8); SWZ_MIN(dq, 16);
#undef SWZ_MAX
#undef SWZ_MIN
        float* qn_l = (float*)(lds + OST_OFF);
        if (lane == 0) { qn_l[wid] = s2; qn_l[NW + wid] = dq; }
        __syncthreads();
        float qm2 = qn_l[0], dmn = qn_l[NW];
#pragma unroll
        for (int i = 1; i < NW; ++i) { qm2 = fmaxf(qm2, qn_l[i]); dmn = fminf(dmn, qn_l[NW + i]); }
        const float B2 = (__builtin_sqrtf(qm2 * kn2) - dmn) * SCALE * 1.0001f + 0.01f;
        const int tchk = QB / KVBLK + lane; bool skip = false;
        if (tchk < NT) skip = (B2 + tbl[KBASE_REV(tchk) + KVBLK - 1] * SCALE) < -ACP_MARGIN;
        const unsigned long long mk = __ballot(skip);
        if (mk) { const int first = __ffsll((long long)mk) - 1 + QB / KVBLK; const int ne = (first + 1) & ~1; NT = ne < NT ? ne : NT; }
    }
    const int ub0 = 4 * hi - (qlo + r32) + TBASE, ua0 = ub0 & 3;
    const float* tlane = (MODE == 0) ? tbl + (ua0 * 1024 + ub0 - ua0) : tbl + 4 * hi;
    float m_reg = -1e30f, l_reg = 0; f32x16 o[4] = {};
    const int sr = tid >> 4, sc = (tid & 15) * 8, vst0 = v_st(sr, sc), vst1 = v_st(32 + sr, sc), kws = KSWZ(sr, sc * 2);
    const int vb0 = (int)(uintptr_t)V_lds + v_rd_base(lane);
    const bf16* Kh = cur.K; const bf16* Vh = cur.V;
#define RESC(a) do { if (__any((a) < 1.f)) { if (hi == 0) al_l[r32] = (a); asm volatile("s_waitcnt lgkmcnt(0)" ::: "memory");              \
                     for (int d_ = 0; d_ < 4; ++d_) for (int r = 0; r < 16; ++r) o[d_][r] *= al_l[crow(r, hi)]; } } while (0)
#define KBASE(t) ((MODE == 1 && ATT_REVERSE) ? (j_hi - 1 - (t)) * KVBLK : (j_lo + (t)) * KVBLK)
#define ACT(t) (MODE != 0 || ((j_lo + (t)) >= (qlo >> 6) - NLEFT && (j_lo + (t)) <= (qlo >> 6)))
#define MASKT(P0_, P1_, t) do { if (MODE == 0 && !SK) { if (!ACT(t)) { const float NEG_ = -__builtin_inff(); _Pragma("unroll") for (int r_ = 0; r_ < 16; ++r_) { P0_[r_] = NEG_; P1_[r_] = NEG_; } } } if (MODE == 1) { const int kb_ = KBASE(t); if (kb_ + KVBLK - 1 > qlo) mask_tile(P0_, P1_, qm - kb_, 0x7fffffffu); } } while (0)
    constexpr int NQL = 8;
#define SEAM_K0() do { VMWN(NQL); SWRITE_HK(0); SBAR(); } while (0)
    f32x16 pA0, pA1, pB0, pB1; float mnA, mnB, alA, alB; bf16x8 pa0, pa1, pa2, pa3;
    SWRITE_HV(0); SBAR();
    if (NT > 1) { SLOAD_H(Kh, Vh, KBASE(1)); }
    SBAR(); qkt<0, SK, true>(pA0, pA1, K_lds, r32, hi, S.qr, ACT(0), tlane + KBASE(0));
    MASKT(pA0, pA1, 0); partialSM(pA0, pA1, m_reg, mnA, alA);
    if (NT > 1) { VMW(); SWRITE_H(1); SBAR(); if (NT > 2) { SLOAD_K(Kh, KBASE(2)); } }
    __syncthreads();
#define HALF_STEP(PX0, PX1, mnX, alX, PY0, PY1, alY, t, KB, VB, SB) do {                                                      \
        SBAR(); qkt<KB, SK, true>(PX0, PX1, K_lds, r32, hi, S.qr, ACT(t), tlane + KBASE(t));                             \
        finishSM(PY0, PY1, alY, l_reg, pa0, pa1, pa2, pa3); SBAR();                                                           \
        if ((t) + 1 < NT) { SWRITE_HK(SB); SBAR(); SLOAD_V(Vh, KBASE((t) + 1)); if ((t) + 2 < NT) { SLOAD_K(Kh, KBASE((t) + 2)); } SBAR(); } \
        pv_tile<VB, SKP>(o, vb0, pa0, pa1, pa2, pa3, ACT((t) - 1)); MASKT(PX0, PX1, (t)); partialSM(PX0, PX1, m_reg, mnX, alX); \
        __syncthreads();                                                                                                      \
        if ((t) + 1 < NT) { SWRITE_HV(SB); }                                                                                  \
        RESC(alX); } while (0)
    for (int t = 1; t + 1 < NT; t += 2) {
        HALF_STEP(pB0, pB1, mnB, alB, pA0, pA1, alA, t, 1, 0, 0);
        HALF_STEP(pA0, pA1, mnA, alA, pB0, pB1, alB, t + 1, 0, 1, 1);
    }
    const bool even = (NT & 1) == 0;
    if (even) { SBAR(); qkt<1, SK, true>(pB0, pB1, K_lds, r32, hi, S.qr, ACT(NT - 1), tlane + KBASE(NT - 1)); SBAR(); }
    SLOAD_H(nxt.K, nxt.V, kbn); SBAR();
#pragma unroll
    for (int d0 = 0; d0 < 8; ++d0) S.qr[d0] = load8(nxt.Q + (size_t)(wid * QBLK + r32) * LD + d0 * 16 + hi * 8);
    SBAR();
    finishSM(pA0, pA1, alA, l_reg, pa0, pa1, pa2, pa3); SBAR();
    pv_tile<0, SKP>(o, vb0, pa0, pa1, pa2, pa3, ACT(even ? NT - 2 : NT - 1));
    if (even) { MASKT(pB0, pB1, NT - 1); partialSM(pB0, pB1, m_reg, mnB, alB); __syncthreads(); RESC(alB);
        finishSM(pB0, pB1, alB, l_reg, pa0, pa1, pa2, pa3); SBAR(); pv_tile<1, SKP>(o, vb0, pa0, pa1, pa2, pa3, ACT(NT - 1)); }
    else { __syncthreads(); }
    SBAR(); SEAM_K0();
    int fetched = -1;
    if (qctr && tid == 0) {
#pragma unroll 1
        for (int k = 0; k < 8; ++k) { const int q = (qhome + k) & 7; const unsigned i = __hip_atomic_fetch_add(qctr + 64 * q, 1u, __ATOMIC_RELAXED, __HIP_MEMORY_SCOPE_AGENT); if (i < 128u) { fetched = q * 128 + (int)i; break; } } }
    build_table<MODE>(tbl, nxt, tid);
    if (hi == 0) li_l[r32] = l_reg; asm volatile("s_waitcnt lgkmcnt(0)" ::: "memory");
    float rli[16];
#pragma unroll
    for (int r = 0; r < 16; ++r) rli[r] = __builtin_amdgcn_rcpf(li_l[crow(r, hi)]);
    bf16* Ow = cur.O + (size_t)(wid * QBLK) * LDO; const bf16* Gw = cur.G + (size_t)(wid * QBLK) * LD;
    unsigned short* stg = (unsigned short*)(lds + OST_OFF) + wid * (QBLK * D);
#pragma unroll
    for (int r = 0; r < 16; ++r) { const int orow = crow(r, hi);
#pragma unroll
        for (int d0 = 0; d0 < 4; ++d0) { const float v = o[d0][r] * rli[r]; stg[orow * D + d0 * 32 + r32] = (unsigned short)cvtpk(v, v); } }
    asm volatile("s_waitcnt lgkmcnt(0)" ::: "memory");
#pragma unroll 2
    for (int i = 0; i < 8; ++i) { const int row = i * 4 + (lane >> 4), ch = lane & 15;
        const u32x4 ov = *(const u32x4*)(stg + row * D + ch * 8);
        const u32x4 gv = *(const AGAS u32x4*)(Gw + (size_t)row * LD + ch * 8);
        u32x4 res;
#pragma unroll
        for (int j = 0; j < 4; ++j) { const float o0 = __uint_as_float(ov[j] << 16), o1 = __uint_as_float(ov[j] & 0xffff0000u);
            const float g0 = __uint_as_float(gv[j] << 16), g1 = __uint_as_float(gv[j] & 0xffff0000u);
            const float s0 = g0 * __builtin_amdgcn_rcpf(1.f + __builtin_amdgcn_exp2f(-1.4426950408889634f * g0));
            const float s1 = g1 * __builtin_amdgcn_rcpf(1.f + __builtin_amdgcn_exp2f(-1.4426950408889634f * g1));
            res[j] = cvtpk(o0 * s0, o1 * s1); }
        *(AGAS u32x4*)(Ow + (size_t)row * LDO + ch * 8) = res; }
    if (qslot && tid == 0) qslot[0] = (unsigned)fetched;
    __syncthreads();
#undef RESC
#undef KBASE
#undef ACT
#undef MASKT
#undef SEAM_K0
#undef HALF_STEP
}
#undef ROW
#undef VMW
#undef VMWN
#undef SLOAD_H
#undef SWRITE_HK
#undef SLOAD_K
#undef SLOAD_V
#undef SWRITE_HV
#undef SWRITE_H
}
constexpr int NWAVES = 8, NTHREADS = NWAVES * 64;
constexpr int BATCH = 2, SEQ = 4096, DM = 2048, DI = 4096, NH = 32, M = BATCH * SEQ;
constexpr int NQKVG = 4 * DI;
constexpr float EPS = 1e-6f;
constexpr size_t MiB = 1u << 20;
constexpr size_t WS_WA_IN = 0;
constexpr size_t WS_WA_OUT = 128 * MiB;
constexpr size_t WS_W5 = 160 * MiB;
constexpr size_t WS_WB_IN1 = 224 * MiB;
constexpr size_t WS_WB_OUT = 256 * MiB;
constexpr size_t WS_FWT = 288 * MiB;
constexpr size_t WS_XN = 289 * MiB;
constexpr size_t WS_QKVG = 321 * MiB;
constexpr size_t WS_OG = 577 * MiB;
constexpr size_t WS_LOGF = 641 * MiB;
constexpr size_t WS_CUM = 642 * MiB;
constexpr size_t WS_CTL = 644 * MiB, CTL_BYTES = 65536;
constexpr size_t WS_QCTR = WS_CTL + 36864;
constexpr size_t WS_KN = WS_CTL + 32768;
constexpr size_t WS_END = 645 * MiB;
constexpr int XN_LDS_PITCH = DM * 2 + 16;
constexpr int XB_LDS_OFF = att::LDS_BYTES;
constexpr int LDS_BYTES = att::LDS_BYTES + 64;
static_assert(LDS_BYTES >= pg8::STAGE_BYTES && LDS_BYTES >= 32 * XN_LDS_PITCH && LDS_BYTES <= 160 * 1024, "LDS map");

#define GAS __attribute__((address_space(1)))
#define LAS __attribute__((address_space(3)))
typedef unsigned short bf16r;
typedef unsigned v4u __attribute__((ext_vector_type(4)));
typedef float f32x4 __attribute__((ext_vector_type(4)));
typedef float f32x16 __attribute__((ext_vector_type(16)));
typedef short bf16x8 __attribute__((ext_vector_type(8)));
#define LDS_WAIT() asm volatile("s_waitcnt lgkmcnt(0)" ::: "memory")
__device__ __forceinline__ unsigned f2bf(float f) { unsigned u = __builtin_bit_cast(unsigned, f); return (u + 0x7fffu + ((u >> 16) & 1u)) >> 16; }
__device__ __forceinline__ unsigned pk2(float lo, float hi) { return f2bf(lo) | (f2bf(hi) << 16); }
__device__ __forceinline__ float wave_sum(float v) {
#define WS_SWZ(o) v += __int_as_float(__builtin_amdgcn_ds_swizzle(__float_as_int(v), 0x1f | ((o) << 10)))
    WS_SWZ(1); WS_SWZ(2); WS_SWZ(4); WS_SWZ(8); WS_SWZ(16);
#undef WS_SWZ
    { auto rr = __builtin_amdgcn_permlane32_swap(__float_as_uint(v), __float_as_uint(v), false, false); v = __uint_as_float(rr[0]) + __uint_as_float(rr[1]); }
    return v;
}
template <int NB>
__device__ __forceinline__ void p0_transpose_item(const float* W, const float* g, int K, int N, bf16r* WT, LAS float* scr, int item, int lane) {
    constexpr int P = 65, LPR = NB / 4, RPI = 64 / LPR, NLD = 64 / RPI;
    const int nkb = K / 64, kb = item % nkb, nb = item / nkb, k0 = 64 * kb, n0 = NB * nb;
    const int lr = lane / LPR, lc = (lane % LPR) * 4;
    f32x4 v[NLD]; float gs[NLD];
#pragma unroll
    for (int i = 0; i < NLD; ++i) { const int kk = i * RPI + lr; v[i] = __builtin_nontemporal_load((const GAS f32x4*)(W + (size_t)(k0 + kk) * N + n0 + lc)); gs[i] = g ? ((const GAS float*)g)[k0 + kk] : 1.f; }
#pragma unroll
    for (int i = 0; i < NLD; ++i) { const int kk = i * RPI + lr; LAS float* d = scr + kk * P + lc; const f32x4 w = v[i] * gs[i]; d[0] = w.x; d[1] = w.y; d[2] = w.z; d[3] = w.w; }
    LDS_WAIT(); asm volatile("" ::: "memory");
    const int c = lane & 7;
#pragma unroll
    for (int j = 0; j < NB / 8; ++j) { const int n = (lane >> 3) + 8 * j; const LAS float* s = scr + (8 * c) * P + n;
        v4u o; o.x = pk2(s[0 * P], s[1 * P]); o.y = pk2(s[2 * P], s[3 * P]); o.z = pk2(s[4 * P], s[5 * P]); o.w = pk2(s[6 * P], s[7 * P]);
        __builtin_nontemporal_store(o, (GAS v4u*)(WT + (size_t)(n0 + n) * K + k0 + 8 * c)); }
    LDS_WAIT(); asm volatile("" ::: "memory");
}
template <bool LCOPY>
__device__ __forceinline__ void rms_row_to_bf16(const float* xrow, bf16r* orow, LAS unsigned char* lrow, int lane) {
    const GAS f32x4* xr = (const GAS f32x4*)xrow + lane;
    f32x4 v[8]; float s = 0.f;
#pragma unroll
    for (int j = 0; j < 8; ++j) { v[j] = xr[64 * j]; s += (v[j].x * v[j].x + v[j].y * v[j].y) + (v[j].z * v[j].z + v[j].w * v[j].w); }
    const float rstd = 1.0f / sqrtf(wave_sum(s) * (1.f / DM) + EPS);
    GAS unsigned long long* o8 = (GAS unsigned long long*)orow + lane;
#pragma unroll
    for (int j = 0; j < 8; ++j) { const unsigned long long w = (unsigned long long)pk2(v[j].x * rstd, v[j].y * rstd) | ((unsigned long long)pk2(v[j].z * rstd, v[j].w * rstd) << 32);
        o8[64 * j] = w; if (LCOPY) *(LAS unsigned long long*)(lrow + (lane + 64 * j) * 8) = w; }
}
__device__ __forceinline__ void rms_row_final(float* xrow, const float* g, int lane) {
    GAS f32x4* xr = (GAS f32x4*)xrow + lane; const GAS f32x4* gr = (const GAS f32x4*)g + lane;
    f32x4 v[8]; float s = 0.f;
#pragma unroll
    for (int j = 0; j < 8; ++j) { v[j] = xr[64 * j]; s += (v[j].x * v[j].x + v[j].y * v[j].y) + (v[j].z * v[j].z + v[j].w * v[j].w); }
    const float rstd = 1.0f / sqrtf(wave_sum(s) * (1.f / DM) + EPS);
#pragma unroll
    for (int j = 0; j < 8; ++j) xr[64 * j] = v[j] * rstd * gr[64 * j];
}


struct Args { const float* in[13]; float* out; unsigned char* ws; int ph_lo, ph_hi; };
constexpr int N_PHASES = 17;

template <int MODE>
__device__ __forceinline__ att::BlockRef attn_ref(int L, const att::bf16* QKVG, att::bf16* OG, const float* tsrc_base, const float* kn_base, int qcol, int kcol, int vcol, int gcol) {
    int bh, qb;
    if (MODE == 0) { bh = L >> 4; qb = ((L & 15) + 5 * (L >> 8)) & 15; }
    else { const int q = L >> 7, idx = L & 127, sl = idx >> 4, hs = sl >> 1;
           qb = 15 - (idx & 15); bh = (sl & 1) * 32 + (hs == 0 ? 31 - q : hs == 1 ? 16 + q : hs == 2 ? 15 - q : q); }
    const int b = bh >> 5, h = bh & 31; const size_t row0 = (size_t)b * SEQ + (size_t)qb * att::QB;
    att::BlockRef r;
    const size_t HS = (size_t)SEQ * 128, qoff = (size_t)qb * att::QB * 128;
    r.Q = QKVG + ((size_t)((qcol >> 12) * 64 + bh)) * HS + qoff; r.G = QKVG + ((size_t)((gcol >> 12) * 64 + bh)) * HS + qoff;
    r.K = QKVG + ((size_t)((kcol >> 12) * 64 + bh)) * HS; r.V = QKVG + ((size_t)((vcol >> 12) * 64 + bh)) * HS;
    r.O = OG + row0 * att::LDO + h * 128; r.P0 = qb * att::QB;
    r.tsrc = (MODE == 0) ? tsrc_base + h * att::NREL : tsrc_base + (size_t)bh * SEQ;
    r.kn = kn_base + bh;
    return r;
}
__device__ __forceinline__ unsigned xb_xcc_id();
__device__ __forceinline__ int attn_fetch(unsigned* ctr, int home) {
#pragma unroll 1
    for (int k = 0; k < 8; ++k) { const int q = (home + k) & 7; const unsigned i = __hip_atomic_fetch_add(ctr + 64 * q, 1u, __ATOMIC_RELAXED, __HIP_MEMORY_SCOPE_AGENT); if (i < 128u) return q * 128 + (int)i; }
    return -1;
}
template <int MODE>
__device__ __forceinline__ void attn_phase(char* lds, int vcu, int G, const att::bf16* QKVG, att::bf16* OG, const float* tsrc_base, const float* kn_base, int qcol, int kcol, int vcol, int gcol,
                                           unsigned* ctr, volatile LAS unsigned* slot) {
    constexpr int TOTAL = BATCH * NH * (SEQ / att::QB);
    att::Seam S;
    if (MODE == 0) {
        int L = vcu; if (L >= TOTAL) return;
        att::BlockRef cur = attn_ref<MODE>(L, QKVG, OG, tsrc_base, kn_base, qcol, kcol, vcol, gcol);
        att::attn_prime<MODE>(cur, lds, S);
        for (;;) {
            const bool last = L + G >= TOTAL;
            const int Ls = last ? L : L + G;
            const att::BlockRef nxt = attn_ref<MODE>(Ls, QKVG, OG, tsrc_base, kn_base, qcol, kcol, vcol, gcol);
            att::attn_block<MODE>(cur, nxt, lds, S);
            if (last) break;
            cur = nxt; L = Ls;
        }
        return;
    }
    if (otid() == 0) { unsigned* c_ = ctr; asm volatile("" : "+s"(c_)); slot[0] = (unsigned)attn_fetch(c_, (int)(xb_xcc_id() & 7u)); }
    __syncthreads();
    int L = __builtin_amdgcn_readfirstlane((int)slot[0]);
    if (L < 0) return;
    att::BlockRef cur = attn_ref<MODE>(L, QKVG, OG, tsrc_base, kn_base, qcol, kcol, vcol, gcol);
    att::attn_prime<MODE>(cur, lds, S);
    if (otid() == 0) { unsigned* c_ = ctr; asm volatile("" : "+s"(c_)); slot[0] = (unsigned)attn_fetch(c_, (int)(xb_xcc_id() & 7u)); }
    __syncthreads();
    int Ln = __builtin_amdgcn_readfirstlane((int)slot[0]);
    for (;;) {
        const bool last = Ln < 0;
        const att::BlockRef nxt = attn_ref<MODE>(last ? L : Ln, QKVG, OG, tsrc_base, kn_base, qcol, kcol, vcol, gcol);
        att::attn_block<MODE>(cur, nxt, lds, S, last ? (unsigned*)nullptr : ctr, (volatile unsigned*)slot, (int)(xb_xcc_id() & 7u));
        if (last) break;
        cur = nxt; L = Ln; Ln = __builtin_amdgcn_readfirstlane((int)slot[0]);
    }
}


#define XB_TMO      128
#define XB_XCNT(j)  (256  + 64 * (j))
#define XB_XSUB(j)  (1280 + 64 * (j))
#define XB_XGEN(j)  (2304 + 64 * (j))
#define XB_TOP      3328
#define XB_TOPGEN   3392
#define XCD_BAR_WORDS 3456
#define XB_SPIN_CAP (1u << 18)

__device__ __forceinline__ unsigned xb_ld(unsigned* p)              { return __hip_atomic_load(p, __ATOMIC_RELAXED, __HIP_MEMORY_SCOPE_AGENT); }
__device__ __forceinline__ unsigned xb_add(unsigned* p, unsigned v) { return __hip_atomic_fetch_add(p, v, __ATOMIC_RELAXED, __HIP_MEMORY_SCOPE_AGENT); }
__device__ __forceinline__ unsigned xb_xcc_id() { return (unsigned)__builtin_amdgcn_s_getreg((3 << 11) | 20) & 0xFu; }
#define XB_SPIN(cond, bar) do { unsigned _sp = 0; while (cond) { __builtin_amdgcn_s_sleep(1); \
    if ((++_sp & 255u) == 0u) { if (xb_ld(&(bar)[XB_TMO])) break; if (_sp > XB_SPIN_CAP) { atomicAdd(&(bar)[XB_TMO], 1u); break; } } } } while (0)

struct XcdBarrier {
    unsigned* bar; unsigned x;
    volatile LAS unsigned* st;
};

__device__ __forceinline__ XcdBarrier xcd_barrier_post(unsigned* bar, volatile LAS unsigned* st) {
    XcdBarrier b; b.bar = bar; b.x = xb_xcc_id(); b.st = st;
    if (threadIdx.x == 0) (void)xb_add(&bar[XB_XCNT(b.x)], 1u);
    return b;
}
__device__ __forceinline__ void xcd_barrier_complete(unsigned* bar, unsigned x, unsigned& nloc, unsigned& nx) {
    const unsigned G = gridDim.x * gridDim.y * gridDim.z;
    unsigned sum, cnt, mine, sp = 0u;
    for (;;) {
        sum = 0u; cnt = 0u; mine = 0u;
#pragma unroll
        for (unsigned j = 0; j < 16; ++j) { const unsigned c = xb_ld(&bar[XB_XCNT(j)]); sum += c; cnt += (c > 0u) ? 1u : 0u; mine = (j == x) ? c : mine; }
        if (sum == G) break;
        __builtin_amdgcn_s_sleep(1);
        if ((++sp & 255u) == 0u) { if (xb_ld(&bar[XB_TMO])) break; if (sp > XB_SPIN_CAP) { atomicAdd(&bar[XB_TMO], 1u); break; } }
    }
    nloc = mine > 0u ? mine : 1u; nx = cnt > 0u ? cnt : 1u;
}

__device__ __forceinline__ void xcd_barrier(const XcdBarrier& b) {
    asm volatile("s_waitcnt vmcnt(0)" ::: "memory");
    __syncthreads();
    if (threadIdx.x == 0) {
        unsigned* bar = b.bar;
        __builtin_amdgcn_s_waitcnt(0);
        unsigned nloc = b.st[0], nx = b.st[1];
        if (nloc == 0u) { xcd_barrier_complete(bar, b.x, nloc, nx); b.st[0] = nloc; b.st[1] = nx; }
        const unsigned old = xb_add(&bar[XB_XSUB(b.x)], 1u);
        const unsigned gen = old / nloc;
        if (old + 1u == (gen + 1u) * nloc) {
            __builtin_amdgcn_fence(__ATOMIC_RELEASE, "agent");
            asm volatile("s_waitcnt vmcnt(0)" ::: "memory");
            const unsigned og = xb_add(&bar[XB_TOP], 1u);
            const unsigned tg = og / nx;
            if (og + 1u == (tg + 1u) * nx) xb_add(&bar[XB_TOPGEN], 1u);
            else XB_SPIN(xb_ld(&bar[XB_TOPGEN]) == tg, bar);
            __builtin_amdgcn_fence(__ATOMIC_ACQUIRE, "agent");
            xb_add(&bar[XB_XGEN(b.x)], 1u);
            asm volatile("s_waitcnt vmcnt(0)" ::: "memory");
        } else {
            XB_SPIN(xb_ld(&bar[XB_XGEN(b.x)]) == gen, bar);
            __builtin_amdgcn_fence(__ATOMIC_ACQUIRE, "agent");
            asm volatile("s_waitcnt vmcnt(0)" ::: "memory");
        }
    }
    __syncthreads();
}


__global__ void __launch_bounds__(NTHREADS, 2) yoco_fwd(Args args) {
    extern __shared__ __attribute__((aligned(16))) unsigned char lds[];
    cg::grid_group grid = cg::this_grid();
    LAS unsigned char* ldsl = (LAS unsigned char*)lds;
    if (threadIdx.x < 16) ((volatile LAS unsigned*)(ldsl + XB_LDS_OFF))[threadIdx.x] = 0u;
    __syncthreads();
    (void)xcd_barrier_post((unsigned*)(args.ws + WS_CTL), (volatile LAS unsigned*)(ldsl + XB_LDS_OFF));
    int kn_done = 0;
#pragma unroll 1
    for (int ph = args.ph_lo; ph < args.ph_hi; ++ph) {
        int G = gridDim.x; int bx = blockIdx.x; asm volatile("" : "+s"(G), "+s"(bx));
        const int vcu = (G % 8 == 0) ? (bx % 8) * (G / 8) + bx / 8 : bx;
        const int tid = otid(), lane = tid & 63, wave = __builtin_amdgcn_readfirstlane(tid >> 6);
        const int gw = vcu * NWAVES + wave, NGW = G * NWAVES;
        unsigned char* ws = args.ws; float* out = args.out; asm volatile("" : "+s"(ws), "+s"(out));
        bf16r* XN = (bf16r*)(ws + WS_XN); bf16r* QKVG = (bf16r*)(ws + WS_QKVG); bf16r* OG = (bf16r*)(ws + WS_OG);
        __syncthreads();
        if (ph == 0) {
            const float* x = args.in[0]; const float* a_norm = args.in[1]; const float* a_w_in = args.in[2]; const float* a_w_out = args.in[4];
            const float* kv_norm = args.in[5]; const float* kv_w = args.in[6]; const float* f_w = args.in[7];
            const float* b_norm = args.in[9]; const float* b_w_in = args.in[10]; const float* b_w_out = args.in[11];
            bf16r* WA_IN = (bf16r*)(ws + WS_WA_IN); bf16r* WA_OUT = (bf16r*)(ws + WS_WA_OUT); bf16r* W5 = (bf16r*)(ws + WS_W5); bf16r* WB_IN1 = (bf16r*)(ws + WS_WB_IN1);
            bf16r* WB_OUT = (bf16r*)(ws + WS_WB_OUT); bf16r* FWT = (bf16r*)(ws + WS_FWT);
            LAS float* scr = (LAS float*)(ldsl + wave * 16640);
            constexpr int I_AIN = (DM / 64) * (NQKVG / 64), I_OUT = (DI / 64) * (DM / 64), I_KV = (DM / 64) * (2 * DI / 64), I_F = (DM / 64) * 1;
            constexpr int NITEMS = 2 * I_AIN + 2 * I_OUT + 3 * I_KV + 2 * I_OUT + I_F;
#pragma unroll 1
            for (int it = gw; it < NITEMS; it += NGW) {
                int r = it; const float* W; const float* g; int K, N; bf16r* WT; bool isf = false;
                if (r < 2 * I_AIN) { const int l = r / I_AIN; r -= l * I_AIN; W = a_w_in + (size_t)l * DM * NQKVG; g = a_norm + l * DM; K = DM; N = NQKVG; WT = WA_IN + (size_t)l * NQKVG * DM; }
                else if ((r -= 2 * I_AIN) < 2 * I_OUT) { const int l = r / I_OUT; r -= l * I_OUT; W = a_w_out + (size_t)l * DI * DM; g = nullptr; K = DI; N = DM; WT = WA_OUT + (size_t)l * DM * DI; }
                else if ((r -= 2 * I_OUT) < I_KV) { W = kv_w; g = kv_norm; K = DM; N = 2 * DI; WT = W5; }
                else if ((r -= I_KV) < 2 * I_KV) { const int l = r / I_KV; r -= l * I_KV; W = b_w_in + (size_t)l * DM * 2 * DI; g = b_norm + l * DM; K = DM; N = 2 * DI; WT = l == 0 ? W5 + (size_t)2 * DI * DM : WB_IN1; }
                else if ((r -= 2 * I_KV) < 2 * I_OUT) { const int l = r / I_OUT; r -= l * I_OUT; W = b_w_out + (size_t)l * DI * DM; g = nullptr; K = DI; N = DM; WT = WB_OUT + (size_t)l * DM * DI; }
                else { r -= 2 * I_OUT; W = f_w; g = kv_norm; K = DM; N = NH; WT = FWT; isf = true; }
                if (isf) p0_transpose_item<32>(W, g, K, N, WT, scr, r, lane); else p0_transpose_item<64>(W, g, K, N, WT, scr, r, lane);
            }
            for (int m = gw; m < M; m += NGW) rms_row_to_bf16<false>(x + (size_t)m * DM, XN + (size_t)m * DM, ldsl, lane);
        } else if (ph == 1 || ph == 5 || ph == 9 || ph == 13) {
            if (ph == 9 && bx < BATCH * NH) {
                const float* src = (const float*)(ws + WS_LOGF) + (size_t)bx * SEQ + tid * 8; float* dst = (float*)(ws + WS_CUM) + (size_t)bx * SEQ + tid * 8;
                f32x4 a = *(const GAS f32x4*)src, b = *(const GAS f32x4*)(src + 4);
                a.y += a.x; a.z += a.y; a.w += a.z; b.x += a.w; b.y += b.x; b.z += b.y; b.w += b.z;
                const float tot = b.w; float inc = tot;
#pragma unroll
                for (int o = 1; o < 64; o <<= 1) { const float t = __shfl_up(inc, o); if (lane >= o) inc += t; }
                LAS float* wt = (LAS float*)ldsl;
                if (lane == 63) wt[wave] = inc;
                LDS_WAIT(); __syncthreads();
                float off = inc - tot;
                for (int w = 0; w < wave; ++w) off += wt[w];
                *(GAS f32x4*)dst = a + off; *(GAS f32x4*)(dst + 4) = b + off;
                __syncthreads();
            }
            const bf16r* Bt = (ph == 1) ? (const bf16r*)(ws + WS_WA_IN) : (ph == 5) ? (const bf16r*)(ws + WS_WA_IN) + (size_t)NQKVG * DM : (ph == 9) ? (const bf16r*)(ws + WS_W5) : (const bf16r*)(ws + WS_WB_IN1);
            const int N = (ph == 13) ? 2 * DI : NQKVG;
            pg8::Gemm g{XN, Bt, M, N, DM}; pg8::StaticOrder S; S.init(M, N, G, bx);
            pg8::EpiBf16 E{QKVG, (ph == 13) ? 2 * DI : 0};
            pg8::gemm_phase<pg8::EpiBf16, pg8::StaticOrder, false, PG8_SP2>(ldsl, g, S, E);
        } else if (ph == 2 || ph == 6) {
            attn_phase<0>((char*)lds, vcu, G, (const att::bf16*)QKVG, (att::bf16*)OG, args.in[3] + (ph == 6 ? NH * att::NREL : 0), (const float*)nullptr, 0, DI, 2 * DI, 3 * DI, (unsigned*)(ws + WS_QCTR) + 512 * (ph == 14), (volatile LAS unsigned*)(ldsl + XB_LDS_OFF) + 8);
        } else if (ph == 10 || ph == 14) {
            if (ATT_ACP && ph == 10 && !kn_done) {
                unsigned* KN = (unsigned*)(ws + WS_KN);
#pragma unroll 1
                for (int job = vcu; job < BATCH * NH * 4; job += G) { const int bh = job >> 2, k0 = (job & 3) * 1024; const bf16r* Kp = QKVG + (size_t)bh * SEQ * 128; float mx = 0.f;
#pragma unroll 1
                    for (int key = k0 + tid; key < k0 + 1024; key += NTHREADS) { float s2 = 0.f;
#pragma unroll
                        for (int j = 0; j < 16; ++j) { const v4u x = *(const GAS v4u*)(Kp + (size_t)key * 128 + j * 8);
#pragma unroll
                            for (int e = 0; e < 4; ++e) { const float a = __uint_as_float(x[e] << 16), b = __uint_as_float(x[e] & 0xffff0000u); s2 = fmaf(a, a, s2); s2 = fmaf(b, b, s2); } }
                        mx = fmaxf(mx, s2); }
                    mx = fmaxf(mx, __int_as_float(__builtin_amdgcn_ds_swizzle(__float_as_int(mx), 0x1f | (1 << 10)))); mx = fmaxf(mx, __int_as_float(__builtin_amdgcn_ds_swizzle(__float_as_int(mx), 0x1f | (2 << 10))));
                    mx = fmaxf(mx, __int_as_float(__builtin_amdgcn_ds_swizzle(__float_as_int(mx), 0x1f | (4 << 10)))); mx = fmaxf(mx, __int_as_float(__builtin_amdgcn_ds_swizzle(__float_as_int(mx), 0x1f | (8 << 10))));
                    mx = fmaxf(mx, __int_as_float(__builtin_amdgcn_ds_swizzle(__float_as_int(mx), 0x1f | (16 << 10))));
                    { auto rr = __builtin_amdgcn_permlane32_swap(__float_as_uint(mx), __float_as_uint(mx), false, false); mx = fmaxf(__uint_as_float(rr[0]), __uint_as_float(rr[1])); }
                    if (lane == 0) atomicMax(KN + bh, __float_as_uint(mx)); }
                kn_done = 1; ph = 9;
            } else {
                attn_phase<1>((char*)lds, vcu, G, (const att::bf16*)QKVG, (att::bf16*)OG, (const float*)(ws + WS_CUM), (const float*)(ws + WS_KN), 2 * DI, 0, DI, 3 * DI, (unsigned*)(ws + WS_QCTR) + 512 * (ph == 14), (volatile LAS unsigned*)(ldsl + XB_LDS_OFF) + 8);
            }
        } else if (ph == 3 || ph == 7 || ph == 11 || ph == 15) {
            const bf16r* Bt = (ph == 3) ? (const bf16r*)(ws + WS_WA_OUT) : (ph == 7) ? (const bf16r*)(ws + WS_WA_OUT) + (size_t)DM * DI : (ph == 11) ? (const bf16r*)(ws + WS_WB_OUT) : (const bf16r*)(ws + WS_WB_OUT) + (size_t)DM * DI;
            pg8::Gemm g{OG, Bt, M, DM, DI}; pg8::StaticOrder S; S.init(M, DM, G, bx);
            pg8::EpiRes E{ph == 3 ? args.in[0] : out, out, DM};
            pg8::gemm_phase<pg8::EpiRes, pg8::StaticOrder, PG8_ALIGN, PG8_SP2>(ldsl, g, S, E);
        } else if (ph == 4 || ph == 12) {
            for (int m = gw; m < M; m += NGW) rms_row_to_bf16<false>(out + (size_t)m * DM, XN + (size_t)m * DM, ldsl, lane);
        } else if (ph == 8) {
            const bf16r* FWT = (const bf16r*)(ws + WS_FWT); float* LOGF = (float*)(ws + WS_LOGF); const float* f_b = args.in[8];
#pragma unroll 1
            for (int grp = vcu; grp < M / 32; grp += G) {
#pragma unroll 1
                for (int i = 0; i < 4; ++i) { const int rl = wave * 4 + i; const int m = grp * 32 + rl;
                    rms_row_to_bf16<true>(out + (size_t)m * DM, XN + (size_t)m * DM, ldsl + rl * XN_LDS_PITCH, lane); }
                LDS_WAIT(); __syncthreads();
                const int r32 = lane & 31, hi5 = lane >> 5;
                f32x16 acc = {};
#pragma unroll
                for (int i = 0; i < 16; ++i) { const int k = wave * 256 + i * 16 + hi5 * 8;
                    const bf16x8 a = *(const LAS bf16x8*)(ldsl + r32 * XN_LDS_PITCH + k * 2);
                    const bf16x8 b = *(const GAS bf16x8*)(FWT + (size_t)r32 * DM + k);
                    acc = __builtin_amdgcn_mfma_f32_32x32x16_bf16(a, b, acc, 0, 0, 0); }
                __syncthreads();
                LAS float* red = (LAS float*)ldsl;
#pragma unroll
                for (int r = 0; r < 16; ++r) red[(wave * 32 + att::crow(r, hi5)) * 33 + r32] = acc[r];
                LDS_WAIT(); __syncthreads();
#pragma unroll
                for (int e = 0; e < 2; ++e) { const int idx = tid * 2 + e, row = idx >> 5, head = idx & 31; float v = ((const GAS float*)f_b)[head];
#pragma unroll
                    for (int w = 0; w < 8; ++w) v += red[(w * 32 + row) * 33 + head];
                    const float ls = fminf(v, 0.f) - log1pf(expf(-fabsf(v)));
                    const int m = grp * 32 + row, b = m / SEQ, s = m % SEQ;
                    ((GAS float*)LOGF)[((size_t)(b * NH + head)) * SEQ + s] = ls; }
                __syncthreads();
            }
        } else {
            for (int m = gw; m < M; m += NGW) rms_row_final(out + (size_t)m * DM, args.in[12], lane);
        }
        if (ph + 1 < args.ph_hi) {
            if (ph == 0) grid.sync();
            else { XcdBarrier xb; xb.bar = (unsigned*)(args.ws + WS_CTL); xb.x = xb_xcc_id(); xb.st = (volatile LAS unsigned*)(ldsl + XB_LDS_OFF); xcd_barrier(xb); }
        }
    }
}

extern "C" void kernel_launch(void* const* d_in, const int* in_sizes, int n_in, void* d_out, int out_size, void* d_ws, size_t ws_size, hipStream_t stream) {
    static int grid = 0;
    if (grid == 0) {
        if (n_in != 13 || in_sizes[0] != M * DM || out_size != M * DM || ws_size < WS_END) { fprintf(stderr, "kernel_launch: shape mismatch n_in %d in0 %d out %d ws %zu\n", n_in, n_in > 0 ? in_sizes[0] : -1, out_size, ws_size); grid = -1; return; }
        int dev = 0, cus = 0, per_cu = 0;
        (void)hipGetDevice(&dev); (void)hipDeviceGetAttribute(&cus, hipDeviceAttributeMultiprocessorCount, dev);
        if (hipFuncSetAttribute((const void*)yoco_fwd, hipFuncAttributeMaxDynamicSharedMemorySize, LDS_BYTES) != hipSuccess) { fprintf(stderr, "kernel_launch: hipFuncSetAttribute failed\n"); grid = -1; return; }
        if (hipOccupancyMaxActiveBlocksPerMultiprocessor(&per_cu, (const void*)yoco_fwd, NTHREADS, LDS_BYTES) != hipSuccess || per_cu < 1) { fprintf(stderr, "kernel_launch: occupancy query says %d\n", per_cu); per_cu = 1; }
        (void)hipGetLastError();
        if (cus <= 0) cus = 256;
        grid = cus;
    }
    if (grid < 0) return;
    if (hipMemsetAsync((char*)d_ws + WS_CTL, 0, CTL_BYTES, stream) != hipSuccess) { fprintf(stderr, "kernel_launch: memset of the barrier words failed\n"); return; }
    Args a{};
    for (int i = 0; i < 13; ++i) a.in[i] = (const float*)d_in[i];
    a.out = (float*)d_out; a.ws = (unsigned char*)d_ws;
    a.ph_lo = 0; a.ph_hi = N_PHASES;
    void* kargs[] = {&a};
    hipError_t e = hipLaunchCooperativeKernel((const void*)yoco_fwd, dim3(grid), dim3(NTHREADS), kargs, LDS_BYTES, stream);
    if (e != hipSuccess) fprintf(stderr, "kernel_launch: cooperative launch failed: %s (grid %d)\n", hipGetErrorString(e), grid);
}
```

```cpp
#include <hip/hip_runtime.h>
#include <hip/hip_bf16.h>
#include <hip/hip_cooperative_groups.h>
#include <cstdio>
#include <cstdint>
namespace cg = cooperative_groups;
__device__ __forceinline__ int otid() { int t = threadIdx.x; asm volatile("" : "+v"(t)); return t; }
namespace pg8 {
#define PG8_LAS __attribute__((address_space(3)))
typedef unsigned short bf16_t;
typedef short bf16x8 __attribute__((ext_vector_type(8)));
typedef float f32x4 __attribute__((ext_vector_type(4)));
typedef unsigned u32x4 __attribute__((ext_vector_type(4)));
constexpr int BM = 256, BK = 64, HALF = 128, HTB = HALF * BK * 2  , STAGE_BYTES = 8 * HTB, NXCD = 8, WGM = 8;

__host__ __device__ __forceinline__ int lds_byte(int r, int c) { const int st = (r >> 4) * 2 + (c >> 5), rr = r & 15, cc = c & 31, ob = rr * 64 + cc * 2; return st * 1024 + (ob ^ (((ob >> 9) & 1) << 5)); }
__host__ __device__ __forceinline__ void stage_rc(int b, int& R, int& C) { const int st = b / 1024, sb = b % 1024, swz = sb ^ (((sb >> 9) & 1) << 5); R = (st >> 1) * 16 + swz / 64; C = (st & 1) * 32 + (swz % 64) / 2; }
__host__ __device__ __forceinline__ int perm32(int rho) { const int n = rho >> 4, i = rho & 15; return 8 * (i >> 2) + 4 * n + (i & 3); }

struct Unit { int pm, pn; };
struct Gemm { const bf16_t* A; const bf16_t* Bt; int M, N, K; };

struct StaticOrder {
    int nM, nN, nwg, G, c;
    __host__ __device__ void init(int M, int N, int G_, int c_) { nM = M / BM; nN = N / BM; nwg = nM * nN; G = G_; c = c_; }
    __host__ __device__ bool next(int i, Unit& u) const {
        const long L = (long)i * G + c; if (L >= nwg) return false;
        int wgid = (int)L; { const int q = nwg / NXCD, r = nwg % NXCD, xcd = wgid % NXCD, off = wgid / NXCD; wgid = (xcd < r ? xcd * (q + 1) : r * (q + 1) + (xcd - r) * q) + off; }
        const int nig = WGM * nN, gid = wgid / nig, fm = gid * WGM, gsz = (nM - fm) < WGM ? (nM - fm) : WGM;
        u.pm = fm + ((wgid % nig) % gsz); u.pn = (wgid % nig) / gsz; return true;
    }
    __device__ __forceinline__ void a_ready(const Unit&) const {}
    __device__ __forceinline__ void done(const Unit&) const {}
};
__device__ __forceinline__ unsigned cvt_pk_bf16(float lo, float hi) { unsigned r; asm volatile("v_cvt_pk_bf16_f32 %0, %1, %2" : "=v"(r) : "v"(lo), "v"(hi)); return r; }
typedef float f32x2 __attribute__((ext_vector_type(2)));
struct EpiBf16 {
    static constexpr bool PERM = true, AFTER_DRAIN = false;
    bf16_t* O; int coff;
    __device__ __forceinline__ void operator()(const f32x4 (&acc)[2][2][4][2], const Unit& u, int wr, int wc, int fr, int fq) const {
        const int row0 = u.pm * BM + wr * 64 + fr, b = row0 >> 12, s0 = row0 & 4095;
#pragma unroll
        for (int bj = 0; bj < 2; ++bj) { const int c = coff + u.pn * BM + bj * HALF + wc * 32 + 8 * fq;
            bf16_t* base = O + ((size_t)((((c >> 12) * 2 + b) * 32 + ((c >> 7) & 31))) * 4096 + s0) * 128 + (c & 127);
#pragma unroll
            for (int ai = 0; ai < 2; ++ai)
#pragma unroll
                for (int m = 0; m < 4; ++m) { const f32x4 v0 = acc[ai][bj][m][0], v1 = acc[ai][bj][m][1];
                    u32x4 w; w.x = cvt_pk_bf16(v0[0], v0[1]); w.y = cvt_pk_bf16(v0[2], v0[3]); w.z = cvt_pk_bf16(v1[0], v1[1]); w.w = cvt_pk_bf16(v1[2], v1[3]);
                    *(__attribute__((address_space(1))) u32x4*)(base + (size_t)(ai * HALF + m * 16) * 128) = w; } }
    }
};
struct EpiRes {
    static constexpr bool PERM = false, AFTER_DRAIN = false;
    const float* res; float* out; int ldc;
    __device__ __forceinline__ void operator()(const f32x4 (&acc)[2][2][4][2], const Unit& u, int wr, int wc, int fr, int fq) const {
        const int row0 = u.pm * BM + wr * 64 + fr, col0 = u.pn * BM + wc * 32 + 4 * fq;
#pragma unroll
        for (int ai = 0; ai < 2; ++ai)
#pragma unroll
            for (int m = 0; m < 4; ++m) { const size_t off = (size_t)(row0 + ai * HALF + m * 16) * ldc + col0;
#pragma unroll
                for (int bj = 0; bj < 2; ++bj)
#pragma unroll
                    for (int n = 0; n < 2; ++n) { const size_t o = off + bj * HALF + n * 16; const f32x4 r = *(const __attribute__((address_space(1))) f32x4*)(res + o); *(__attribute__((address_space(1))) f32x4*)(out + o) = r + acc[ai][bj][m][n]; } }
    }
};
template <class Epi, class Sched, bool ALIGN_EPI = false, bool SP2 = false>
__device__ __forceinline__ void gemm_phase(PG8_LAS unsigned char* lds, const Gemm g, const Sched& S, const Epi& E) {
    const int tid = otid(), wid = __builtin_amdgcn_readfirstlane(tid >> 6), lane = tid & 63, wr = wid >> 2, wc = wid & 3, fr = lane & 15, fq = lane >> 4;
    const int K = g.K, nt = K / BK;
    unsigned voffA[2], voffB[2];
#pragma unroll
    for (int i = 0; i < 2; ++i) { int R, C; stage_rc(tid * 16 + i * 8192, R, C); const int Rb = Epi::PERM ? ((R & ~31) + perm32(R & 31)) : R;
        voffA[i] = (unsigned)(R * K + C) * 2u; voffB[i] = (unsigned)(Rb * K + C) * 2u; }
    const size_t kstep = (size_t)(BK * 2);
    const size_t hstep = (size_t)HALF * K * 2;
    const size_t tstep = 2 * hstep;
    const unsigned ldsw = (unsigned)wid * 1024u;
    const int aoff = lds_byte(wr * 64 + fr, fq * 8), boff = lds_byte(wc * 32 + fr, fq * 8);
#define PG8_SA(b, h) (((b) * 2 + (h)) * HTB)
#define PG8_SB(b, h) ((4 + (b) * 2 + (h)) * HTB)
#define PG8_STAGE(bufoff, gbase, voff) do { _Pragma("unroll") for (int _i = 0; _i < 2; ++_i) \
        __builtin_amdgcn_global_load_lds((const unsigned*)((const char*)(gbase) + (voff)[_i]), (PG8_LAS unsigned*)(lds + (bufoff) + ldsw + _i * 8192), 16, 0, 0); } while (0)
#define PG8_LDA(dst, b, h) do { _Pragma("unroll") for (int m = 0; m < 4; ++m) _Pragma("unroll") for (int k = 0; k < 2; ++k) dst[m][k] = *(const PG8_LAS bf16x8*)(lds + PG8_SA(b, h) + aoff + m * 2048 + k * 1024); } while (0)
#define PG8_LDB(dst, b, h) do { _Pragma("unroll") for (int n = 0; n < 2; ++n) _Pragma("unroll") for (int k = 0; k < 2; ++k) dst[n][k] = *(const PG8_LAS bf16x8*)(lds + PG8_SB(b, h) + boff + n * 2048 + k * 1024); } while (0)
#define PG8_MMA(ai, bj, At, Bt) do { __builtin_amdgcn_s_setprio(1); _Pragma("unroll") for (int m = 0; m < 4; ++m) _Pragma("unroll") for (int n = 0; n < 2; ++n) _Pragma("unroll") for (int k = 0; k < 2; ++k) \
        acc[ai][bj][m][n] = __builtin_amdgcn_mfma_f32_16x16x32_bf16(Bt[n][k], At[m][k], acc[ai][bj][m][n], 0, 0, 0); __builtin_amdgcn_s_setprio(0); } while (0)
#define PG8_WAIT_V(n) asm volatile("s_waitcnt vmcnt(" #n ")" ::: "memory")
#define PG8_WAIT_L(n) asm volatile("s_waitcnt lgkmcnt(" #n ")" ::: "memory")
#define PG8_BAR __builtin_amdgcn_s_barrier()
#define PG8_SCHED __builtin_amdgcn_sched_barrier(0)
    Unit cur, nxt; int ui = 0;
    if (!S.next(0, cur)) return;
    f32x4 acc[2][2][4][2];
#pragma unroll
    for (int a = 0; a < 2; ++a)
#pragma unroll
        for (int b = 0; b < 2; ++b)
#pragma unroll
            for (int m = 0; m < 4; ++m)
#pragma unroll
                for (int n = 0; n < 2; ++n) acc[a][b][m][n] = (f32x4){0.f, 0.f, 0.f, 0.f};
    bf16x8 At[4][2], B0[2][2], B1[2][2];
    const char* cA = (const char*)g.A + (size_t)cur.pm * tstep; const char* cB = (const char*)g.Bt + (size_t)cur.pn * tstep;
    S.a_ready(cur);
    if constexpr (SP2) {
        PG8_STAGE(PG8_SB(0, 0), cB, voffB); PG8_STAGE(PG8_SB(0, 1), cB + hstep, voffB); PG8_STAGE(PG8_SA(0, 0), cA, voffA); PG8_STAGE(PG8_SA(0, 1), cA + hstep, voffA);
        if (wr == 1) PG8_BAR;
        PG8_WAIT_V(2); PG8_BAR;
        PG8_STAGE(PG8_SB(1, 0), cB + kstep, voffB); PG8_STAGE(PG8_SA(1, 0), cA + kstep, voffA); PG8_STAGE(PG8_SB(1, 1), cB + hstep + kstep, voffB);
        PG8_WAIT_V(6); PG8_BAR;
    } else {
        PG8_STAGE(PG8_SB(0, 0), cB, voffB); PG8_STAGE(PG8_SA(0, 0), cA, voffA); PG8_STAGE(PG8_SB(0, 1), cB + hstep, voffB); PG8_STAGE(PG8_SA(0, 1), cA + hstep, voffA);
        if (wr == 1) PG8_BAR;
        PG8_WAIT_V(4); PG8_BAR;
        PG8_STAGE(PG8_SB(1, 0), cB + kstep, voffB); PG8_STAGE(PG8_SA(1, 0), cA + kstep, voffA); PG8_STAGE(PG8_SB(1, 1), cB + hstep + kstep, voffB);
        PG8_WAIT_V(6); PG8_BAR;
    }
    for (;;) {
        const bool has_next = S.next(ui + 1, nxt);
        const char* nA = has_next ? (const char*)g.A + (size_t)nxt.pm * tstep : cA; const char* nB = has_next ? (const char*)g.Bt + (size_t)nxt.pn * tstep : cB;
        for (int t = 0; t < nt; t += 2) {
            const bool last = (t == nt - 2);
            const char* a1 = cA + (size_t)(t + 1) * kstep;
            const char* a2 = last ? nA : cA + (size_t)(t + 2) * kstep; const char* b2 = last ? nB : cB + (size_t)(t + 2) * kstep;
            const char* a3 = a2 + kstep; const char* b3 = b2 + kstep;
            if (last && has_next) S.a_ready(nxt);
            if constexpr (SP2) {
            PG8_LDB(B0, 0, 0); PG8_LDB(B1, 0, 1); PG8_SCHED; PG8_LDA(At, 0, 0); PG8_STAGE(PG8_SA(1, 1), a1 + hstep, voffA);
            PG8_WAIT_V(8); PG8_WAIT_L(0); PG8_BAR; PG8_MMA(0, 0, At, B0); PG8_MMA(0, 1, At, B1); PG8_BAR; PG8_SCHED;
            PG8_LDA(At, 0, 1); PG8_STAGE(PG8_SB(0, 0), b2, voffB); PG8_STAGE(PG8_SB(0, 1), b2 + hstep, voffB); PG8_STAGE(PG8_SA(0, 0), a2, voffA);
            PG8_WAIT_V(8); PG8_WAIT_L(0); PG8_BAR; PG8_MMA(1, 0, At, B0); PG8_MMA(1, 1, At, B1); PG8_BAR; PG8_SCHED;
            PG8_LDB(B0, 1, 0); PG8_LDB(B1, 1, 1); PG8_SCHED; PG8_LDA(At, 1, 0); PG8_STAGE(PG8_SA(0, 1), a2 + hstep, voffA);
            PG8_WAIT_V(8); PG8_WAIT_L(0); PG8_BAR; PG8_MMA(0, 0, At, B0); PG8_MMA(0, 1, At, B1); PG8_BAR; PG8_SCHED;
            PG8_LDA(At, 1, 1); PG8_STAGE(PG8_SB(1, 0), b3, voffB); PG8_STAGE(PG8_SB(1, 1), b3 + hstep, voffB); PG8_STAGE(PG8_SA(1, 0), a3, voffA);
            PG8_WAIT_V(8); PG8_WAIT_L(0); PG8_BAR; PG8_MMA(1, 0, At, B0); PG8_MMA(1, 1, At, B1); PG8_BAR; PG8_SCHED;
            } else {
            PG8_LDB(B0, 0, 0); PG8_SCHED; PG8_LDA(At, 0, 0); PG8_STAGE(PG8_SA(1, 1), a1 + hstep, voffA);
            PG8_WAIT_L(8); PG8_BAR; PG8_WAIT_L(0); PG8_MMA(0, 0, At, B0); PG8_BAR; PG8_SCHED;
            PG8_LDB(B1, 0, 1); PG8_STAGE(PG8_SB(0, 0), b2, voffB);
            PG8_BAR; PG8_WAIT_L(0); PG8_MMA(0, 1, At, B1); PG8_BAR;
            PG8_LDA(At, 0, 1); PG8_STAGE(PG8_SA(0, 0), a2, voffA);
            PG8_BAR; PG8_WAIT_L(0); PG8_MMA(1, 0, At, B0); PG8_BAR; PG8_SCHED;
            PG8_STAGE(PG8_SB(0, 1), b2 + hstep, voffB);
            PG8_WAIT_V(6); PG8_BAR; PG8_MMA(1, 1, At, B1); PG8_BAR;
            PG8_LDB(B0, 1, 0); PG8_SCHED; PG8_LDA(At, 1, 0); PG8_STAGE(PG8_SA(0, 1), a2 + hstep, voffA);
            PG8_WAIT_L(8); PG8_BAR; PG8_WAIT_L(0); PG8_MMA(0, 0, At, B0); PG8_BAR; PG8_SCHED;
            PG8_LDB(B1, 1, 1); PG8_STAGE(PG8_SB(1, 0), b3, voffB);
            PG8_BAR; PG8_WAIT_L(0); PG8_MMA(0, 1, At, B1); PG8_BAR;
            PG8_LDA(At, 1, 1); PG8_STAGE(PG8_SA(1, 0), a3, voffA);
            PG8_BAR; PG8_WAIT_L(0); PG8_MMA(1, 0, At, B0); PG8_BAR; PG8_SCHED;
            PG8_STAGE(PG8_SB(1, 1), b3 + hstep, voffB);
            PG8_WAIT_V(6); PG8_BAR; PG8_MMA(1, 1, At, B1); PG8_BAR;
            }
        }
        if constexpr (ALIGN_EPI) { if (wr == 0) PG8_BAR; }
        if constexpr (!Epi::AFTER_DRAIN) { E(acc, cur, wr, wc, fr, fq); S.done(cur); }
        if (!has_next) break;
#pragma unroll
        for (int a = 0; a < 2; ++a)
#pragma unroll
            for (int b = 0; b < 2; ++b)
#pragma unroll
                for (int m = 0; m < 4; ++m)
#pragma unroll
                    for (int n = 0; n < 2; ++n) acc[a][b][m][n] = (f32x4){0.f, 0.f, 0.f, 0.f};
        cur = nxt; cA = nA; cB = nB; ++ui;
        if constexpr (ALIGN_EPI) { if (wr == 1) PG8_BAR; }
    }
    PG8_WAIT_V(0);
    if constexpr (!ALIGN_EPI) { if (wr == 0) PG8_BAR; }
    PG8_BAR;
    if constexpr (Epi::AFTER_DRAIN) { E.fused(acc, cur, wr, wc, fr, fq, lds, wid, lane); S.done(cur); }
#undef PG8_SA
#undef PG8_SB
#undef PG8_STAGE
#undef PG8_LDA
#undef PG8_LDB
#undef PG8_MMA
#undef PG8_WAIT_V
#undef PG8_WAIT_L
#undef PG8_BAR
#undef PG8_SCHED
}
}
#ifndef PG8_SP2
#define PG8_SP2 true
#endif
#ifndef PG8_ALIGN
#define PG8_ALIGN true
#endif
namespace att {
using bf16 = __hip_bfloat16;
typedef short bf16x8 __attribute__((ext_vector_type(8)));
typedef short s16x4 __attribute__((ext_vector_type(4)));
typedef float f32x16 __attribute__((ext_vector_type(16)));
typedef float f32x4 __attribute__((ext_vector_type(4)));
typedef unsigned u32x4 __attribute__((ext_vector_type(4)));
constexpr int D = 128, SEQ = 4096, NH = 32;
constexpr int LD = 128;
constexpr int LDO = 4096;
constexpr float SCALE = 0.08838834764831845f, INV_SCALE = 11.313708498984761f;
constexpr float THR = 8.f;
#ifndef ATT_ACP
#define ATT_ACP 1
#endif
constexpr float ACP_MARGIN = 30.f;
#ifndef ATT_SKIP
#define ATT_SKIP true
#endif
#ifndef ATT_SKIP_PV
#define ATT_SKIP_PV false
#endif
constexpr int NW = 8, QBLK = 32, KVBLK = 64, QB = NW * QBLK;
constexpr int SHM_V = KVBLK * D * 2, SHM_K = KVBLK * D * 2;
constexpr int WS_OFF = 2 * SHM_V + 2 * SHM_K, TBL_OFF = WS_OFF + NW * 64 * 4, OST_OFF = TBL_OFF + SEQ * 4, LDS_BYTES = OST_OFF + NW * QBLK * D * 2;
constexpr int NLEFT = 8, RELC = 256, NREL = 513, TOFF = NLEFT * 64 + 63, TPAD = 256, TLEN = TOFF + 64 + 2 * TPAD;

#define KSWZ(row, colB) ((row) * 256 + ((colB) ^ (((row) & 7) << 4)))
#define SBAR() __builtin_amdgcn_sched_barrier(0)
__device__ __forceinline__ int v_st(int k, int c) { const int kk = (k & ~0xC) | ((k & 4) << 1) | ((k & 8) >> 1); return ((kk >> 3) * 4 + (c >> 5)) * 512 + ((kk & 7) * 32 + (c & 31)) * 2; }
__device__ __forceinline__ int v_rd_base(int lane) { return ((lane & 3) << 3) | (((lane >> 2) & 3) << 6) | (((lane >> 4) & 1) << 5) | (((lane >> 5) & 1) << 8); }
constexpr int v_rd_off(int d0, int ks, int half) { return d0 * 512 + ks * 4096 + half * 2048; }
__device__ __forceinline__ int crow(int r, int hi) { return (r & 3) + 8 * (r >> 2) + 4 * hi; }
__device__ __forceinline__ unsigned cvtpk(float lo, float hi) { unsigned r; asm volatile("v_cvt_pk_bf16_f32 %0, %1, %2" : "=v"(r) : "v"(lo), "v"(hi)); return r; }
#define AGAS __attribute__((address_space(1)))
__device__ __forceinline__ bf16x8 load8(const bf16* p) { return *(const AGAS bf16x8*)p; }
__device__ __forceinline__ void mask_tile(f32x16& p0, f32x16& p1, int dq, unsigned W) {
    const float NEG = -__builtin_inff();
#pragma unroll
    for (int r = 0; r < 16; ++r) {
        const int c = (r & 3) + 8 * (r >> 2);
        if ((unsigned)(dq - c) >= W) p0[r] = NEG;
        if ((unsigned)(dq - c - 32) >= W) p1[r] = NEG;
    }
}
__device__ __forceinline__ void partialSM(f32x16& p0, f32x16& p1, float& m_reg, float& mn, float& alpha) {
    float pmax = p0[0]; for (int r = 1; r < 16; ++r) pmax = fmaxf(pmax, p0[r]); for (int r = 0; r < 16; ++r) pmax = fmaxf(pmax, p1[r]);
    { auto rr = __builtin_amdgcn_permlane32_swap(__float_as_uint(pmax), __float_as_uint(pmax), false, false);
      pmax = fmaxf(__uint_as_float(rr[0]), __uint_as_float(rr[1])); }
    constexpr float C2 = 1.4426950408889634f * SCALE;
    if (__builtin_expect(__all((pmax - m_reg) * SCALE <= THR), 1)) { mn = m_reg; alpha = 1.f; }
    else { mn = fmaxf(m_reg, pmax); alpha = __builtin_amdgcn_exp2f((m_reg - mn) * C2); m_reg = mn; }
    const float mnL = -mn * C2;
    { typedef float f32x2p __attribute__((ext_vector_type(2)));
      float c2r = C2; asm volatile("" : "+v"(c2r)); const f32x2p cv = {c2r, c2r}, mv = {mnL, mnL};
#pragma unroll
      for (int r = 0; r < 16; r += 2) { f32x2p a = {p0[r], p0[r + 1]}, b = {p1[r], p1[r + 1]};
          a = __builtin_elementwise_fma(a, cv, mv); b = __builtin_elementwise_fma(b, cv, mv); p0[r] = a.x; p0[r + 1] = a.y; p1[r] = b.x; p1[r + 1] = b.y; } }
    for (int r = 0; r < 16; ++r) p0[r] = __builtin_amdgcn_exp2f(p0[r]);
}
__device__ __forceinline__ void finishSM(f32x16& p0, f32x16& p1, float alpha, float& l_reg, bf16x8& pa0, bf16x8& pa1, bf16x8& pa2, bf16x8& pa3) {
    for (int r = 0; r < 16; ++r) p1[r] = __builtin_amdgcn_exp2f(p1[r]);
    float ps; { typedef float f32x2p __attribute__((ext_vector_type(2)));
      f32x2p s0 = {p0[0], p0[1]}, s1 = {p1[0], p1[1]};
#pragma unroll
      for (int r = 2; r < 16; r += 2) { s0 += (f32x2p){p0[r], p0[r + 1]}; s1 += (f32x2p){p1[r], p1[r + 1]}; }
      s0 += s1; ps = s0.x + s0.y; }
    { auto rr = __builtin_amdgcn_permlane32_swap(__float_as_uint(ps), __float_as_uint(ps), false, false);
      ps = __uint_as_float(rr[0]) + __uint_as_float(rr[1]); }
    l_reg = l_reg * alpha + ps;
#define PK4(P, B_, OUT) do { unsigned a0 = cvtpk(P[B_+0], P[B_+1]), a1 = cvtpk(P[B_+2], P[B_+3]);                          \
        unsigned b0 = cvtpk(P[B_+4], P[B_+5]), b1 = cvtpk(P[B_+6], P[B_+7]);                                             \
        auto r0 = __builtin_amdgcn_permlane32_swap(a0, b0, false, false); auto r1 = __builtin_amdgcn_permlane32_swap(a1, b1, false, false); \
        u32x4 w = {r0[0], r1[0], r0[1], r1[1]}; OUT = *reinterpret_cast<bf16x8*>(&w); } while (0)
    PK4(p0, 0, pa0); PK4(p0, 8, pa1); PK4(p1, 0, pa2); PK4(p1, 8, pa3);
#undef PK4
}
template <int KB, bool SK, bool AL16>
__device__ __forceinline__ void qkt(f32x16& p0, f32x16& p1, const char* K_lds, int r32, int hi, const bf16x8* qr, bool act, const float* tb) {
    if (SK && !act) { const float NEG = -__builtin_inff();
#pragma unroll
        for (int r = 0; r < 16; ++r) { p0[r] = NEG; p1[r] = NEG; } return; }
    if (AL16) {
#pragma unroll
        for (int q = 0; q < 4; ++q) { const f32x4 a = *(const f32x4*)(tb + 8 * q), b = *(const f32x4*)(tb + 32 + 8 * q);
#pragma unroll
            for (int e = 0; e < 4; ++e) { p0[4 * q + e] = a[e]; p1[4 * q + e] = b[e]; } }
    } else {
#pragma unroll
        for (int r = 0; r < 16; ++r) { p0[r] = tb[(r & 3) + 8 * (r >> 2)]; p1[r] = tb[32 + (r & 3) + 8 * (r >> 2)]; }
    }
    const char* kb[4];
#pragma unroll
    for (int dd = 0; dd < 4; ++dd) kb[dd] = K_lds + KB * SHM_K + KSWZ(r32, (dd * 16 + hi * 8) * 2);
#pragma unroll
    for (int d0 = 0; d0 < 8; ++d0) { const char* a = kb[d0 & 3] + (d0 >> 2) * 128;
        bf16x8 b0 = *reinterpret_cast<const bf16x8*>(a);
        bf16x8 b1 = *reinterpret_cast<const bf16x8*>(a + 32 * 256);
        p0 = __builtin_amdgcn_mfma_f32_32x32x16_bf16(b0, qr[d0], p0, 0, 0, 0);
        p1 = __builtin_amdgcn_mfma_f32_32x32x16_bf16(b1, qr[d0], p1, 0, 0, 0); }
}
template <int VB, bool SK>
__device__ __forceinline__ void pv_tile(f32x16* o, int vb0, bf16x8 pa0, bf16x8 pa1, bf16x8 pa2, bf16x8 pa3, bool act) {
    if (SK && !act) return;
#define TRRD(dst, off) asm volatile("ds_read_b64_tr_b16 %0, %1 offset:%2" : "=&v"(dst) : "v"(vb0), "i"(off) : "memory")
#define PV_D0(d0) do { s16x4 l0, l1, l2, l3, h0, h1, h2, h3; constexpr int b_ = VB * SHM_V + v_rd_off(d0, 0, 0); \
        TRRD(l0, b_); TRRD(h0, b_ + 2048); TRRD(l1, b_ + 4096); TRRD(h1, b_ + 6144); TRRD(l2, b_ + 8192); TRRD(h2, b_ + 10240); TRRD(l3, b_ + 12288); TRRD(h3, b_ + 14336); \
        asm volatile("s_waitcnt lgkmcnt(0)" ::: "memory"); SBAR();   \
        o[d0] = __builtin_amdgcn_mfma_f32_32x32x16_bf16(pa0, (bf16x8){l0[0], l0[1], l0[2], l0[3], h0[0], h0[1], h0[2], h0[3]}, o[d0], 0, 0, 0);   \
        o[d0] = __builtin_amdgcn_mfma_f32_32x32x16_bf16(pa1, (bf16x8){l1[0], l1[1], l1[2], l1[3], h1[0], h1[1], h1[2], h1[3]}, o[d0], 0, 0, 0);   \
        o[d0] = __builtin_amdgcn_mfma_f32_32x32x16_bf16(pa2, (bf16x8){l2[0], l2[1], l2[2], l2[3], h2[0], h2[1], h2[2], h2[3]}, o[d0], 0, 0, 0);   \
        o[d0] = __builtin_amdgcn_mfma_f32_32x32x16_bf16(pa3, (bf16x8){l3[0], l3[1], l3[2], l3[3], h3[0], h3[1], h3[2], h3[3]}, o[d0], 0, 0, 0); } while (0)
    PV_D0(0); PV_D0(1); PV_D0(2); PV_D0(3);
#undef PV_D0
#undef TRRD
}
struct BlockRef { const bf16* Q; const bf16* K; const bf16* V; const bf16* G; bf16* O; const float* tsrc; const float* kn; int P0; };
struct Seam { bf16x8 qr[8]; bf16x8 st_v0, st_v1, st_k0, st_k1; };
template <int MODE> __device__ __forceinline__ int blk_jlo(int P0) { if (MODE == 0) { const int j = P0 / KVBLK - NLEFT; return j > 0 ? j : 0; } return 0; }
#ifndef ATT_REVERSE
#define ATT_REVERSE true
#endif
template <int MODE> __device__ __forceinline__ int blk_first(int P0) { return (MODE == 1 && ATT_REVERSE) ? (P0 / KVBLK + QB / KVBLK - 1) * KVBLK : blk_jlo<MODE>(P0) * KVBLK; }
template <int MODE> __device__ __forceinline__ void build_table(float* tbl, const BlockRef& r, int tid) {
    if (MODE == 0) {
        for (int u = tid; u < TLEN; u += NW * 64) { int d = TOFF + TPAD - u; d = d < -RELC ? -RELC : (d > RELC ? RELC : d); tbl[u] = ((const AGAS float*)r.tsrc)[d + RELC] * INV_SCALE; }
    } else {
        const float c0 = ((const AGAS float*)r.tsrc)[r.P0]; const int n = r.P0 + QB;
        for (int s = tid * 4; s < n; s += NW * 64 * 4) { const f32x4 v = *(const AGAS f32x4*)(r.tsrc + s); *(f32x4*)(tbl + s) = (c0 - v) * INV_SCALE; }
    }
}
#define ROW(p, k0, rr) ((p) + (size_t)((k0) + (rr)) * LD + sc)
#define VMW() asm volatile("s_waitcnt vmcnt(0)" ::: "memory")
#define VMWN(n) asm volatile("s_waitcnt vmcnt(%0)" :: "i"(n) : "memory")
#define SLOAD_H(Kp, Vp, k0) do { S.st_v0 = load8(ROW(Vp, k0, sr)); S.st_v1 = load8(ROW(Vp, k0, 32 + sr));              \
                         S.st_k0 = load8(ROW(Kp, k0, sr)); S.st_k1 = load8(ROW(Kp, k0, 32 + sr)); } while (0)
#define SLOAD_K(Kp, k0) do { S.st_k0 = load8(ROW(Kp, k0, sr)); S.st_k1 = load8(ROW(Kp, k0, 32 + sr)); } while (0)
#define SLOAD_V(Vp, k0) do { S.st_v0 = load8(ROW(Vp, k0, sr)); S.st_v1 = load8(ROW(Vp, k0, 32 + sr)); } while (0)
#define SWRITE_HK(bf) do { *(bf16x8*)(K_lds + (bf) * SHM_K + kws) = S.st_k0; *(bf16x8*)(K_lds + (bf) * SHM_K + kws + 32 * 256) = S.st_k1; } while (0)
#define SWRITE_HV(bf) do { *(bf16x8*)(V_lds + (bf) * SHM_V + vst0) = S.st_v0; *(bf16x8*)(V_lds + (bf) * SHM_V + vst1) = S.st_v1; } while (0)
#define SWRITE_H(bf) do { SWRITE_HV(bf); SWRITE_HK(bf); } while (0)
template <int MODE>
__device__ __forceinline__ void attn_prime(const BlockRef& cur, char* lds, Seam& S) {
    const int tid = otid(), wid = __builtin_amdgcn_readfirstlane(tid >> 6), lane = tid & 63, r32 = lane & 31, hi = lane >> 5;
    const int sr = tid >> 4, sc = (tid & 15) * 8, kws = KSWZ(sr, sc * 2); char* K_lds = lds + 2 * SHM_V;
    const int kb0 = blk_first<MODE>(cur.P0);
    for (int d0 = 0; d0 < 8; ++d0) S.qr[d0] = load8(cur.Q + (size_t)(wid * QBLK + r32) * LD + d0 * 16 + hi * 8);
    SLOAD_H(cur.K, cur.V, kb0);
    build_table<MODE>((float*)(lds + TBL_OFF), cur, tid);
    VMW(); SWRITE_HK(0);
    __syncthreads();
}
#define KBASE_REV(t) ((j_hi - 1 - (t)) * KVBLK)
template <int MODE>
__device__ __forceinline__ void attn_block(const BlockRef& cur, const BlockRef& nxt, char* lds, Seam& S, unsigned* qctr = nullptr, volatile unsigned* qslot = nullptr, int qhome = 0) {
    constexpr bool SK = (MODE == 0) && ATT_SKIP; constexpr bool SKP = (MODE == 0) && ATT_SKIP_PV;
    const int tid = otid(), wid = __builtin_amdgcn_readfirstlane(tid >> 6), lane = tid & 63, r32 = lane & 31, hi = lane >> 5;
    const int j_lo = blk_jlo<MODE>(cur.P0);
    const int j_hi = cur.P0 / KVBLK + QB / KVBLK;
    int NT = j_hi - j_lo;
    const int kbn = blk_first<MODE>(nxt.P0);
    const int qlo = cur.P0 + wid * QBLK, qm = qlo + r32 - 4 * hi;
    char* V_lds = lds; char* K_lds = lds + 2 * SHM_V;
    float* ws = (float*)(lds + WS_OFF) + wid * 64; float* li_l = ws, * al_l = ws + 32;
    float* tbl = (float*)(lds + TBL_OFF);
    if (MODE == 1 && ATT_ACP && ATT_REVERSE) {
        const float kn2 = *(const AGAS float*)cur.kn;
        float s2 = 0.f, dq = 0.f;
        { const bf16* krow = cur.K + (size_t)(qlo + r32) * LD + hi * 8;
#pragma unroll
          for (int d0 = 0; d0 < 8; ++d0) { const bf16x8 kk = load8(krow + d0 * 16);
#pragma unroll
              for (int e = 0; e < 8; ++e) { const float v = __uint_as_float((unsigned)(unsigned short)S.qr[d0][e] << 16), w = __uint_as_float((unsigned)(unsigned short)kk[e] << 16); s2 = fmaf(v, v, s2); dq = fmaf(v, w, dq); } } }
        { auto rr = __builtin_amdgcn_permlane32_swap(__float_as_uint(s2), __float_as_uint(s2), false, false); s2 = __uint_as_float(rr[0]) + __uint_as_float(rr[1]); }
        { auto rr = __builtin_amdgcn_permlane32_swap(__float_as_uint(dq), __float_as_uint(dq), false, false); dq = __uint_as_float(rr[0]) + __uint_as_float(rr[1]); }
#define SWZ_MAX(x, o) x = fmaxf(x, __int_as_float(__builtin_amdgcn_ds_swizzle(__float_as_int(x), 0x1f | ((o) << 10))))
#define SWZ_MIN(x, o) x = fminf(x, __int_as_float(__builtin_amdgcn_ds_swizzle(__float_as_int(x), 0x1f | ((o) << 10))))
        SWZ_MAX(s2, 1); SWZ_MAX(s2, 2); SWZ_MAX(s2, 4); SWZ_MAX(s2, 8); SWZ_MAX(s2, 16);
        SWZ_MIN(dq, 1); SWZ_MIN(dq, 2); SWZ_MIN(dq, 4); SWZ_MIN(dq, 8); SWZ_MIN(dq, 16);
#undef SWZ_MAX
#undef SWZ_MIN
        float* qn_l = (float*)(lds + OST_OFF);
        if (lane == 0) { qn_l[wid] = s2; qn_l[NW + wid] = dq; }
        __syncthreads();
        float qm2 = qn_l[0], dmn = qn_l[NW];
#pragma unroll
        for (int i = 1; i < NW; ++i) { qm2 = fmaxf(qm2, qn_l[i]); dmn = fminf(dmn, qn_l[NW + i]); }
        const float B2 = (__builtin_sqrtf(qm2 * kn2) - dmn) * SCALE * 1.0001f + 0.01f;
        const int tchk = QB / KVBLK + lane; bool skip = false;
        if (tchk < NT) skip = (B2 + tbl[KBASE_REV(tchk) + KVBLK - 1] * SCALE) < -ACP_MARGIN;
        const unsigned long long mk = __ballot(skip);
        if (mk) { const int first = __ffsll((long long)mk) - 1 + QB / KVBLK; const int ne = (first + 1) & ~1; NT = ne < NT ? ne : NT; }
    }
    const float* tlane = (MODE == 0) ? tbl + (4 * hi - (qlo + r32) + TOFF + TPAD) : tbl + 4 * hi;
    float m_reg = -1e30f, l_reg = 0; f32x16 o[4] = {};
    const int sr = tid >> 4, sc = (tid & 15) * 8, vst0 = v_st(sr, sc), vst1 = v_st(32 + sr, sc), kws = KSWZ(sr, sc * 2);
    const int vb0 = (int)(uintptr_t)V_lds + v_rd_base(lane);
    const bf16* Kh = cur.K; const bf16* Vh = cur.V;
#define RESC(a) do { if (__any((a) < 1.f)) { if (hi == 0) al_l[r32] = (a); asm volatile("s_waitcnt lgkmcnt(0)" ::: "memory");              \
                     for (int d_ = 0; d_ < 4; ++d_) for (int r = 0; r < 16; ++r) o[d_][r] *= al_l[crow(r, hi)]; } } while (0)
#define KBASE(t) ((MODE == 1 && ATT_REVERSE) ? (j_hi - 1 - (t)) * KVBLK : (j_lo + (t)) * KVBLK)
#define ACT(t) (MODE != 0 || ((j_lo + (t)) >= (qlo >> 6) - NLEFT && (j_lo + (t)) <= (qlo >> 6)))
#define MASKT(P0_, P1_, t) do { if (MODE == 0 && !SK) { if (!ACT(t)) { const float NEG_ = -__builtin_inff(); _Pragma("unroll") for (int r_ = 0; r_ < 16; ++r_) { P0_[r_] = NEG_; P1_[r_] = NEG_; } } } if (MODE == 1) { const int kb_ = KBASE(t); if (kb_ + KVBLK - 1 > qlo) mask_tile(P0_, P1_, qm - kb_, 0x7fffffffu); } } while (0)
    constexpr int NQL = 8;
#define SEAM_K0() do { VMWN(NQL); SWRITE_HK(0); SBAR(); } while (0)
    f32x16 pA0, pA1, pB0, pB1; float mnA, mnB, alA, alB; bf16x8 pa0, pa1, pa2, pa3;
    SWRITE_HV(0); SBAR();
    if (NT > 1) { SLOAD_H(Kh, Vh, KBASE(1)); }
    SBAR(); qkt<0, SK, MODE == 1>(pA0, pA1, K_lds, r32, hi, S.qr, ACT(0), tlane + KBASE(0));
    MASKT(pA0, pA1, 0); partialSM(pA0, pA1, m_reg, mnA, alA);
    if (NT > 1) { VMW(); SWRITE_H(1); SBAR(); if (NT > 2) { SLOAD_K(Kh, KBASE(2)); } }
    __syncthreads();
#define HALF_STEP(PX0, PX1, mnX, alX, PY0, PY1, alY, t, KB, VB, SB) do {                                                      \
        SBAR(); qkt<KB, SK, MODE == 1>(PX0, PX1, K_lds, r32, hi, S.qr, ACT(t), tlane + KBASE(t));                             \
        finishSM(PY0, PY1, alY, l_reg, pa0, pa1, pa2, pa3); SBAR();                                                           \
        if ((t) + 1 < NT) { SWRITE_HK(SB); SBAR(); SLOAD_V(Vh, KBASE((t) + 1)); if ((t) + 2 < NT) { SLOAD_K(Kh, KBASE((t) + 2)); } SBAR(); } \
        pv_tile<VB, SKP>(o, vb0, pa0, pa1, pa2, pa3, ACT((t) - 1)); MASKT(PX0, PX1, (t)); partialSM(PX0, PX1, m_reg, mnX, alX); \
        __syncthreads();                                                                                                      \
        if ((t) + 1 < NT) { SWRITE_HV(SB); }                                                                                  \
        RESC(alX); } while (0)
    for (int t = 1; t + 1 < NT; t += 2) {
        HALF_STEP(pB0, pB1, mnB, alB, pA0, pA1, alA, t, 1, 0, 0);
        HALF_STEP(pA0, pA1, mnA, alA, pB0, pB1, alB, t + 1, 0, 1, 1);
    }
    const bool even = (NT & 1) == 0;
    if (even) { SBAR(); qkt<1, SK, MODE == 1>(pB0, pB1, K_lds, r32, hi, S.qr, ACT(NT - 1), tlane + KBASE(NT - 1)); SBAR(); }
    SLOAD_H(nxt.K, nxt.V, kbn); SBAR();
#pragma unroll
    for (int d0 = 0; d0 < 8; ++d0) S.qr[d0] = load8(nxt.Q + (size_t)(wid * QBLK + r32) * LD + d0 * 16 + hi * 8);
    SBAR();
    finishSM(pA0, pA1, alA, l_reg, pa0, pa1, pa2, pa3); SBAR();
    pv_tile<0, SKP>(o, vb0, pa0, pa1, pa2, pa3, ACT(even ? NT - 2 : NT - 1));
    if (even) { MASKT(pB0, pB1, NT - 1); partialSM(pB0, pB1, m_reg, mnB, alB); __syncthreads(); RESC(alB);
        finishSM(pB0, pB1, alB, l_reg, pa0, pa1, pa2, pa3); SBAR(); pv_tile<1, SKP>(o, vb0, pa0, pa1, pa2, pa3, ACT(NT - 1)); }
    else { __syncthreads(); }
    SBAR(); SEAM_K0();
    int fetched = -1;
    if (qctr && tid == 0) {
#pragma unroll 1
        for (int k = 0; k < 8; ++k) { const int q = (qhome + k) & 7; const unsigned i = __hip_atomic_fetch_add(qctr + 64 * q, 1u, __ATOMIC_RELAXED, __HIP_MEMORY_SCOPE_AGENT); if (i < 128u) { fetched = q * 128 + (int)i; break; } } }
    build_table<MODE>(tbl, nxt, tid);
    if (hi == 0) li_l[r32] = l_reg; asm volatile("s_waitcnt lgkmcnt(0)" ::: "memory");
    float rli[16];
#pragma unroll
    for (int r = 0; r < 16; ++r) rli[r] = __builtin_amdgcn_rcpf(li_l[crow(r, hi)]);
    bf16* Ow = cur.O + (size_t)(wid * QBLK) * LDO; const bf16* Gw = cur.G + (size_t)(wid * QBLK) * LD;
    unsigned short* stg = (unsigned short*)(lds + OST_OFF) + wid * (QBLK * D);
#pragma unroll
    for (int r = 0; r < 16; ++r) { const int orow = crow(r, hi);
#pragma unroll
        for (int d0 = 0; d0 < 4; ++d0) { const float v = o[d0][r] * rli[r]; stg[orow * D + d0 * 32 + r32] = (unsigned short)cvtpk(v, v); } }
    asm volatile("s_waitcnt lgkmcnt(0)" ::: "memory");
#pragma unroll 2
    for (int i = 0; i < 8; ++i) { const int row = i * 4 + (lane >> 4), ch = lane & 15;
        const u32x4 ov = *(const u32x4*)(stg + row * D + ch * 8);
        const u32x4 gv = *(const AGAS u32x4*)(Gw + (size_t)row * LD + ch * 8);
        u32x4 res;
#pragma unroll
        for (int j = 0; j < 4; ++j) { const float o0 = __uint_as_float(ov[j] << 16), o1 = __uint_as_float(ov[j] & 0xffff0000u);
            const float g0 = __uint_as_float(gv[j] << 16), g1 = __uint_as_float(gv[j] & 0xffff0000u);
            const float s0 = g0 * __builtin_amdgcn_rcpf(1.f + __builtin_amdgcn_exp2f(-1.4426950408889634f * g0));
            const float s1 = g1 * __builtin_amdgcn_rcpf(1.f + __builtin_amdgcn_exp2f(-1.4426950408889634f * g1));
            res[j] = cvtpk(o0 * s0, o1 * s1); }
        *(AGAS u32x4*)(Ow + (size_t)row * LDO + ch * 8) = res; }
    if (qslot && tid == 0) qslot[0] = (unsigned)fetched;
    __syncthreads();
#undef RESC
#undef KBASE
#undef ACT
#undef MASKT
#undef SEAM_K0
#undef HALF_STEP
}
#undef ROW
#undef VMW
#undef VMWN
#undef SLOAD_H
#undef SWRITE_HK
#undef SLOAD_K
#undef SLOAD_V
#undef SWRITE_HV
#undef SWRITE_H
}
constexpr int NWAVES = 8, NTHREADS = NWAVES * 64;
constexpr int BATCH = 2, SEQ = 4096, DM = 2048, DI = 4096, NH = 32, M = BATCH * SEQ;
constexpr int NQKVG = 4 * DI;
constexpr float EPS = 1e-6f;
constexpr size_t MiB = 1u << 20;
constexpr size_t WS_WA_IN = 0;
constexpr size_t WS_WA_OUT = 128 * MiB;
constexpr size_t WS_W5 = 160 * MiB;
constexpr size_t WS_WB_IN1 = 224 * MiB;
constexpr size_t WS_WB_OUT = 256 * MiB;
constexpr size_t WS_FWT = 288 * MiB;
constexpr size_t WS_XN = 289 * MiB;
constexpr size_t WS_QKVG = 321 * MiB;
constexpr size_t WS_OG = 577 * MiB;
constexpr size_t WS_LOGF = 641 * MiB;
constexpr size_t WS_CUM = 642 * MiB;
constexpr size_t WS_CTL = 644 * MiB, CTL_BYTES = 65536;
constexpr size_t WS_QCTR = WS_CTL + 36864;
constexpr size_t WS_KN = WS_CTL + 32768;
constexpr size_t WS_END = 645 * MiB;
constexpr int XN_LDS_PITCH = DM * 2 + 16;
constexpr int XB_LDS_OFF = att::LDS_BYTES;
constexpr int LDS_BYTES = att::LDS_BYTES + 64;
static_assert(LDS_BYTES >= pg8::STAGE_BYTES && LDS_BYTES >= 32 * XN_LDS_PITCH && LDS_BYTES <= 160 * 1024, "LDS map");

#define GAS __attribute__((address_space(1)))
#define LAS __attribute__((address_space(3)))
typedef unsigned short bf16r;
typedef unsigned v4u __attribute__((ext_vector_type(4)));
typedef float f32x4 __attribute__((ext_vector_type(4)));
typedef float f32x16 __attribute__((ext_vector_type(16)));
typedef short bf16x8 __attribute__((ext_vector_type(8)));
#define LDS_WAIT() asm volatile("s_waitcnt lgkmcnt(0)" ::: "memory")
__device__ __forceinline__ unsigned f2bf(float f) { unsigned u = __builtin_bit_cast(unsigned, f); return (u + 0x7fffu + ((u >> 16) & 1u)) >> 16; }
__device__ __forceinline__ unsigned pk2(float lo, float hi) { return f2bf(lo) | (f2bf(hi) << 16); }
__device__ __forceinline__ float wave_sum(float v) {
#define WS_SWZ(o) v += __int_as_float(__builtin_amdgcn_ds_swizzle(__float_as_int(v), 0x1f | ((o) << 10)))
    WS_SWZ(1); WS_SWZ(2); WS_SWZ(4); WS_SWZ(8); WS_SWZ(16);
#undef WS_SWZ
    { auto rr = __builtin_amdgcn_permlane32_swap(__float_as_uint(v), __float_as_uint(v), false, false); v = __uint_as_float(rr[0]) + __uint_as_float(rr[1]); }
    return v;
}
template <int NB>
__device__ __forceinline__ void p0_transpose_item(const float* W, const float* g, int K, int N, bf16r* WT, LAS float* scr, int item, int lane) {
    constexpr int P = 65, LPR = NB / 4, RPI = 64 / LPR, NLD = 64 / RPI;
    const int nkb = K / 64, kb = item % nkb, nb = item / nkb, k0 = 64 * kb, n0 = NB * nb;
    const int lr = lane / LPR, lc = (lane % LPR) * 4;
    f32x4 v[NLD]; float gs[NLD];
#pragma unroll
    for (int i = 0; i < NLD; ++i) { const int kk = i * RPI + lr; v[i] = __builtin_nontemporal_load((const GAS f32x4*)(W + (size_t)(k0 + kk) * N + n0 + lc)); gs[i] = g ? ((const GAS float*)g)[k0 + kk] : 1.f; }
#pragma unroll
    for (int i = 0; i < NLD; ++i) { const int kk = i * RPI + lr; LAS float* d = scr + kk * P + lc; const f32x4 w = v[i] * gs[i]; d[0] = w.x; d[1] = w.y; d[2] = w.z; d[3] = w.w; }
    LDS_WAIT(); asm volatile("" ::: "memory");
    const int c = lane & 7;
#pragma unroll
    for (int j = 0; j < NB / 8; ++j) { const int n = (lane >> 3) + 8 * j; const LAS float* s = scr + (8 * c) * P + n;
        v4u o; o.x = pk2(s[0 * P], s[1 * P]); o.y = pk2(s[2 * P], s[3 * P]); o.z = pk2(s[4 * P], s[5 * P]); o.w = pk2(s[6 * P], s[7 * P]);
        __builtin_nontemporal_store(o, (GAS v4u*)(WT + (size_t)(n0 + n) * K + k0 + 8 * c)); }
    LDS_WAIT(); asm volatile("" ::: "memory");
}
template <bool LCOPY>
__device__ __forceinline__ void rms_row_to_bf16(const float* xrow, bf16r* orow, LAS unsigned char* lrow, int lane) {
    const GAS f32x4* xr = (const GAS f32x4*)xrow + lane;
    f32x4 v[8]; float s = 0.f;
#pragma unroll
    for (int j = 0; j < 8; ++j) { v[j] = xr[64 * j]; s += (v[j].x * v[j].x + v[j].y * v[j].y) + (v[j].z * v[j].z + v[j].w * v[j].w); }
    const float rstd = 1.0f / sqrtf(wave_sum(s) * (1.f / DM) + EPS);
    GAS unsigned long long* o8 = (GAS unsigned long long*)orow + lane;
#pragma unroll
    for (int j = 0; j < 8; ++j) { const unsigned long long w = (unsigned long long)pk2(v[j].x * rstd, v[j].y * rstd) | ((unsigned long long)pk2(v[j].z * rstd, v[j].w * rstd) << 32);
        o8[64 * j] = w; if (LCOPY) *(LAS unsigned long long*)(lrow + (lane + 64 * j) * 8) = w; }
}
__device__ __forceinline__ void rms_row_final(float* xrow, const float* g, int lane) {
    GAS f32x4* xr = (GAS f32x4*)xrow + lane; const GAS f32x4* gr = (const GAS f32x4*)g + lane;
    f32x4 v[8]; float s = 0.f;
#pragma unroll
    for (int j = 0; j < 8; ++j) { v[j] = xr[64 * j]; s += (v[j].x * v[j].x + v[j].y * v[j].y) + (v[j].z * v[j].z + v[j].w * v[j].w); }
    const float rstd = 1.0f / sqrtf(wave_sum(s) * (1.f / DM) + EPS);
#pragma unroll
    for (int j = 0; j < 8; ++j) xr[64 * j] = v[j] * rstd * gr[64 * j];
}


struct Args { const float* in[13]; float* out; unsigned char* ws; int ph_lo, ph_hi; };
constexpr int N_PHASES = 17;

template <int MODE>
__device__ __forceinline__ att::BlockRef attn_ref(int L, const att::bf16* QKVG, att::bf16* OG, const float* tsrc_base, const float* kn_base, int qcol, int kcol, int vcol, int gcol) {
    int bh, qb;
    if (MODE == 0) { bh = L >> 4; qb = ((L & 15) + 5 * (L >> 8)) & 15; }
    else { const int q = L >> 7, idx = L & 127, sl = idx >> 4, hs = sl >> 1;
           qb = 15 - (idx & 15); bh = (sl & 1) * 32 + (hs == 0 ? 31 - q : hs == 1 ? 16 + q : hs == 2 ? 15 - q : q); }
    const int b = bh >> 5, h = bh & 31; const size_t row0 = (size_t)b * SEQ + (size_t)qb * att::QB;
    att::BlockRef r;
    const size_t HS = (size_t)SEQ * 128, qoff = (size_t)qb * att::QB * 128;
    r.Q = QKVG + ((size_t)((qcol >> 12) * 64 + bh)) * HS + qoff; r.G = QKVG + ((size_t)((gcol >> 12) * 64 + bh)) * HS + qoff;
    r.K = QKVG + ((size_t)((kcol >> 12) * 64 + bh)) * HS; r.V = QKVG + ((size_t)((vcol >> 12) * 64 + bh)) * HS;
    r.O = OG + row0 * att::LDO + h * 128; r.P0 = qb * att::QB;
    r.tsrc = (MODE == 0) ? tsrc_base + h * att::NREL : tsrc_base + (size_t)bh * SEQ;
    r.kn = kn_base + bh;
    return r;
}
__device__ __forceinline__ unsigned xb_xcc_id();
__device__ __forceinline__ int attn_fetch(unsigned* ctr, int home) {
#pragma unroll 1
    for (int k = 0; k < 8; ++k) { const int q = (home + k) & 7; const unsigned i = __hip_atomic_fetch_add(ctr + 64 * q, 1u, __ATOMIC_RELAXED, __HIP_MEMORY_SCOPE_AGENT); if (i < 128u) return q * 128 + (int)i; }
    return -1;
}
template <int MODE>
__device__ __forceinline__ void attn_phase(char* lds, int vcu, int G, const att::bf16* QKVG, att::bf16* OG, const float* tsrc_base, const float* kn_base, int qcol, int kcol, int vcol, int gcol,
                                           unsigned* ctr, volatile LAS unsigned* slot) {
    constexpr int TOTAL = BATCH * NH * (SEQ / att::QB);
    att::Seam S;
    if (MODE == 0) {
        int L = vcu; if (L >= TOTAL) return;
        att::BlockRef cur = attn_ref<MODE>(L, QKVG, OG, tsrc_base, kn_base, qcol, kcol, vcol, gcol);
        att::attn_prime<MODE>(cur, lds, S);
        for (;;) {
            const bool last = L + G >= TOTAL;
            const int Ls = last ? L : L + G;
            const att::BlockRef nxt = attn_ref<MODE>(Ls, QKVG, OG, tsrc_base, kn_base, qcol, kcol, vcol, gcol);
            att::attn_block<MODE>(cur, nxt, lds, S);
            if (last) break;
            cur = nxt; L = Ls;
        }
        return;
    }
    if (otid() == 0) { unsigned* c_ = ctr; asm volatile("" : "+s"(c_)); slot[0] = (unsigned)attn_fetch(c_, (int)(xb_xcc_id() & 7u)); }
    __syncthreads();
    int L = __builtin_amdgcn_readfirstlane((int)slot[0]);
    if (L < 0) return;
    att::BlockRef cur = attn_ref<MODE>(L, QKVG, OG, tsrc_base, kn_base, qcol, kcol, vcol, gcol);
    att::attn_prime<MODE>(cur, lds, S);
    if (otid() == 0) { unsigned* c_ = ctr; asm volatile("" : "+s"(c_)); slot[0] = (unsigned)attn_fetch(c_, (int)(xb_xcc_id() & 7u)); }
    __syncthreads();
    int Ln = __builtin_amdgcn_readfirstlane((int)slot[0]);
    for (;;) {
        const bool last = Ln < 0;
        const att::BlockRef nxt = attn_ref<MODE>(last ? L : Ln, QKVG, OG, tsrc_base, kn_base, qcol, kcol, vcol, gcol);
        att::attn_block<MODE>(cur, nxt, lds, S, last ? (unsigned*)nullptr : ctr, (volatile unsigned*)slot, (int)(xb_xcc_id() & 7u));
        if (last) break;
        cur = nxt; L = Ln; Ln = __builtin_amdgcn_readfirstlane((int)slot[0]);
    }
}


#define XB_TMO      128
#define XB_XCNT(j)  (256  + 64 * (j))
#define XB_XSUB(j)  (1280 + 64 * (j))
#define XB_XGEN(j)  (2304 + 64 * (j))
#define XB_TOP      3328
#define XB_TOPGEN   3392
#define XCD_BAR_WORDS 3456
#define XB_SPIN_CAP (1u << 18)

__device__ __forceinline__ unsigned xb_ld(unsigned* p)              { return __hip_atomic_load(p, __ATOMIC_RELAXED, __HIP_MEMORY_SCOPE_AGENT); }
__device__ __forceinline__ unsigned xb_add(unsigned* p, unsigned v) { return __hip_atomic_fetch_add(p, v, __ATOMIC_RELAXED, __HIP_MEMORY_SCOPE_AGENT); }
__device__ __forceinline__ unsigned xb_xcc_id() { return (unsigned)__builtin_amdgcn_s_getreg((3 << 11) | 20) & 0xFu; }
#define XB_SPIN(cond, bar) do { unsigned _sp = 0; while (cond) { __builtin_amdgcn_s_sleep(1); \
    if ((++_sp & 255u) == 0u) { if (xb_ld(&(bar)[XB_TMO])) break; if (_sp > XB_SPIN_CAP) { atomicAdd(&(bar)[XB_TMO], 1u); break; } } } } while (0)

struct XcdBarrier {
    unsigned* bar; unsigned x;
    volatile LAS unsigned* st;
};

__device__ __forceinline__ XcdBarrier xcd_barrier_post(unsigned* bar, volatile LAS unsigned* st) {
    XcdBarrier b; b.bar = bar; b.x = xb_xcc_id(); b.st = st;
    if (threadIdx.x == 0) (void)xb_add(&bar[XB_XCNT(b.x)], 1u);
    return b;
}
__device__ __forceinline__ void xcd_barrier_complete(unsigned* bar, unsigned x, unsigned& nloc, unsigned& nx) {
    const unsigned G = gridDim.x * gridDim.y * gridDim.z;
    unsigned sum, cnt, mine, sp = 0u;
    for (;;) {
        sum = 0u; cnt = 0u; mine = 0u;
#pragma unroll
        for (unsigned j = 0; j < 16; ++j) { const unsigned c = xb_ld(&bar[XB_XCNT(j)]); sum += c; cnt += (c > 0u) ? 1u : 0u; mine = (j == x) ? c : mine; }
        if (sum == G) break;
        __builtin_amdgcn_s_sleep(1);
        if ((++sp & 255u) == 0u) { if (xb_ld(&bar[XB_TMO])) break; if (sp > XB_SPIN_CAP) { atomicAdd(&bar[XB_TMO], 1u); break; } }
    }
    nloc = mine > 0u ? mine : 1u; nx = cnt > 0u ? cnt : 1u;
}

__device__ __forceinline__ void xcd_barrier(const XcdBarrier& b) {
    asm volatile("s_waitcnt vmcnt(0)" ::: "memory");
    __syncthreads();
    if (threadIdx.x == 0) {
        unsigned* bar = b.bar;
        __builtin_amdgcn_s_waitcnt(0);
        unsigned nloc = b.st[0], nx = b.st[1];
        if (nloc == 0u) { xcd_barrier_complete(bar, b.x, nloc, nx); b.st[0] = nloc; b.st[1] = nx; }
        const unsigned old = xb_add(&bar[XB_XSUB(b.x)], 1u);
        const unsigned gen = old / nloc;
        if (old + 1u == (gen + 1u) * nloc) {
            __builtin_amdgcn_fence(__ATOMIC_RELEASE, "agent");
            asm volatile("s_waitcnt vmcnt(0)" ::: "memory");
            const unsigned og = xb_add(&bar[XB_TOP], 1u);
            const unsigned tg = og / nx;
            if (og + 1u == (tg + 1u) * nx) xb_add(&bar[XB_TOPGEN], 1u);
            else XB_SPIN(xb_ld(&bar[XB_TOPGEN]) == tg, bar);
            __builtin_amdgcn_fence(__ATOMIC_ACQUIRE, "agent");
            xb_add(&bar[XB_XGEN(b.x)], 1u);
            asm volatile("s_waitcnt vmcnt(0)" ::: "memory");
        } else {
            XB_SPIN(xb_ld(&bar[XB_XGEN(b.x)]) == gen, bar);
            __builtin_amdgcn_fence(__ATOMIC_ACQUIRE, "agent");
            asm volatile("s_waitcnt vmcnt(0)" ::: "memory");
        }
    }
    __syncthreads();
}


__global__ void __launch_bounds__(NTHREADS, 2) yoco_fwd(Args args) {
    extern __shared__ __attribute__((aligned(16))) unsigned char lds[];
    cg::grid_group grid = cg::this_grid();
    LAS unsigned char* ldsl = (LAS unsigned char*)lds;
    if (threadIdx.x < 16) ((volatile LAS unsigned*)(ldsl + XB_LDS_OFF))[threadIdx.x] = 0u;
    __syncthreads();
    (void)xcd_barrier_post((unsigned*)(args.ws + WS_CTL), (volatile LAS unsigned*)(ldsl + XB_LDS_OFF));
    int kn_done = 0;
#pragma unroll 1
    for (int ph = args.ph_lo; ph < args.ph_hi; ++ph) {
        int G = gridDim.x; int bx = blockIdx.x; asm volatile("" : "+s"(G), "+s"(bx));
        const int vcu = (G % 8 == 0) ? (bx % 8) * (G / 8) + bx / 8 : bx;
        const int tid = otid(), lane = tid & 63, wave = __builtin_amdgcn_readfirstlane(tid >> 6);
        const int gw = vcu * NWAVES + wave, NGW = G * NWAVES;
        unsigned char* ws = args.ws; float* out = args.out; asm volatile("" : "+s"(ws), "+s"(out));
        bf16r* XN = (bf16r*)(ws + WS_XN); bf16r* QKVG = (bf16r*)(ws + WS_QKVG); bf16r* OG = (bf16r*)(ws + WS_OG);
        __syncthreads();
        if (ph == 0) {
            const float* x = args.in[0]; const float* a_norm = args.in[1]; const float* a_w_in = args.in[2]; const float* a_w_out = args.in[4];
            const float* kv_norm = args.in[5]; const float* kv_w = args.in[6]; const float* f_w = args.in[7];
            const float* b_norm = args.in[9]; const float* b_w_in = args.in[10]; const float* b_w_out = args.in[11];
            bf16r* WA_IN = (bf16r*)(ws + WS_WA_IN); bf16r* WA_OUT = (bf16r*)(ws + WS_WA_OUT); bf16r* W5 = (bf16r*)(ws + WS_W5); bf16r* WB_IN1 = (bf16r*)(ws + WS_WB_IN1);
            bf16r* WB_OUT = (bf16r*)(ws + WS_WB_OUT); bf16r* FWT = (bf16r*)(ws + WS_FWT);
            LAS float* scr = (LAS float*)(ldsl + wave * 16640);
            constexpr int I_AIN = (DM / 64) * (NQKVG / 64), I_OUT = (DI / 64) * (DM / 64), I_KV = (DM / 64) * (2 * DI / 64), I_F = (DM / 64) * 1;
            constexpr int NITEMS = 2 * I_AIN + 2 * I_OUT + 3 * I_KV + 2 * I_OUT + I_F;
#pragma unroll 1
            for (int it = gw; it < NITEMS; it += NGW) {
                int r = it; const float* W; const float* g; int K, N; bf16r* WT; bool isf = false;
                if (r < 2 * I_AIN) { const int l = r / I_AIN; r -= l * I_AIN; W = a_w_in + (size_t)l * DM * NQKVG; g = a_norm + l * DM; K = DM; N = NQKVG; WT = WA_IN + (size_t)l * NQKVG * DM; }
                else if ((r -= 2 * I_AIN) < 2 * I_OUT) { const int l = r / I_OUT; r -= l * I_OUT; W = a_w_out + (size_t)l * DI * DM; g = nullptr; K = DI; N = DM; WT = WA_OUT + (size_t)l * DM * DI; }
                else if ((r -= 2 * I_OUT) < I_KV) { W = kv_w; g = kv_norm; K = DM; N = 2 * DI; WT = W5; }
                else if ((r -= I_KV) < 2 * I_KV) { const int l = r / I_KV; r -= l * I_KV; W = b_w_in + (size_t)l * DM * 2 * DI; g = b_norm + l * DM; K = DM; N = 2 * DI; WT = l == 0 ? W5 + (size_t)2 * DI * DM : WB_IN1; }
                else if ((r -= 2 * I_KV) < 2 * I_OUT) { const int l = r / I_OUT; r -= l * I_OUT; W = b_w_out + (size_t)l * DI * DM; g = nullptr; K = DI; N = DM; WT = WB_OUT + (size_t)l * DM * DI; }
                else { r -= 2 * I_OUT; W = f_w; g = kv_norm; K = DM; N = NH; WT = FWT; isf = true; }
                if (isf) p0_transpose_item<32>(W, g, K, N, WT, scr, r, lane); else p0_transpose_item<64>(W, g, K, N, WT, scr, r, lane);
            }
            for (int m = gw; m < M; m += NGW) rms_row_to_bf16<false>(x + (size_t)m * DM, XN + (size_t)m * DM, ldsl, lane);
        } else if (ph == 1 || ph == 5 || ph == 9 || ph == 13) {
            if (ph == 9 && bx < BATCH * NH) {
                const float* src = (const float*)(ws + WS_LOGF) + (size_t)bx * SEQ + tid * 8; float* dst = (float*)(ws + WS_CUM) + (size_t)bx * SEQ + tid * 8;
                f32x4 a = *(const GAS f32x4*)src, b = *(const GAS f32x4*)(src + 4);
                a.y += a.x; a.z += a.y; a.w += a.z; b.x += a.w; b.y += b.x; b.z += b.y; b.w += b.z;
                const float tot = b.w; float inc = tot;
#pragma unroll
                for (int o = 1; o < 64; o <<= 1) { const float t = __shfl_up(inc, o); if (lane >= o) inc += t; }
                LAS float* wt = (LAS float*)ldsl;
                if (lane == 63) wt[wave] = inc;
                LDS_WAIT(); __syncthreads();
                float off = inc - tot;
                for (int w = 0; w < wave; ++w) off += wt[w];
                *(GAS f32x4*)dst = a + off; *(GAS f32x4*)(dst + 4) = b + off;
                __syncthreads();
            }
            const bf16r* Bt = (ph == 1) ? (const bf16r*)(ws + WS_WA_IN) : (ph == 5) ? (const bf16r*)(ws + WS_WA_IN) + (size_t)NQKVG * DM : (ph == 9) ? (const bf16r*)(ws + WS_W5) : (const bf16r*)(ws + WS_WB_IN1);
            const int N = (ph == 13) ? 2 * DI : NQKVG;
            pg8::Gemm g{XN, Bt, M, N, DM}; pg8::StaticOrder S; S.init(M, N, G, bx);
            pg8::EpiBf16 E{QKVG, (ph == 13) ? 2 * DI : 0};
            pg8::gemm_phase<pg8::EpiBf16, pg8::StaticOrder, false, PG8_SP2>(ldsl, g, S, E);
        } else if (ph == 2 || ph == 6) {
            attn_phase<0>((char*)lds, vcu, G, (const att::bf16*)QKVG, (att::bf16*)OG, args.in[3] + (ph == 6 ? NH * att::NREL : 0), (const float*)nullptr, 0, DI, 2 * DI, 3 * DI, (unsigned*)(ws + WS_QCTR) + 512 * (ph == 14), (volatile LAS unsigned*)(ldsl + XB_LDS_OFF) + 8);
        } else if (ph == 10 || ph == 14) {
            if (ATT_ACP && ph == 10 && !kn_done) {
                unsigned* KN = (unsigned*)(ws + WS_KN);
#pragma unroll 1
                for (int job = vcu; job < BATCH * NH * 4; job += G) { const int bh = job >> 2, k0 = (job & 3) * 1024; const bf16r* Kp = QKVG + (size_t)bh * SEQ * 128; float mx = 0.f;
#define SWZ_ADD(x, o) x += __int_as_float(__builtin_amdgcn_ds_swizzle(__float_as_int(x), 0x1f | ((o) << 10)))
#define SWZ_MAX(x, o) x = fmaxf(x, __int_as_float(__builtin_amdgcn_ds_swizzle(__float_as_int(x), 0x1f | ((o) << 10))))
#pragma unroll 4
                    for (int kk = 0; kk < 1024; kk += 32) { const int key = k0 + kk + wave * 4 + (lane >> 4);
                        const v4u x = *(const GAS v4u*)(Kp + (size_t)key * 128 + (lane & 15) * 8); float s2 = 0.f;
#pragma unroll
                        for (int e = 0; e < 4; ++e) { const float p = __uint_as_float(x[e] << 16), q = __uint_as_float(x[e] & 0xffff0000u); s2 = fmaf(p, p, s2); s2 = fmaf(q, q, s2); }
                        SWZ_ADD(s2, 1); SWZ_ADD(s2, 2); SWZ_ADD(s2, 4); SWZ_ADD(s2, 8);
                        mx = fmaxf(mx, s2); }
                    SWZ_MAX(mx, 16);
#undef SWZ_ADD
#undef SWZ_MAX
                    { auto rr = __builtin_amdgcn_permlane32_swap(__float_as_uint(mx), __float_as_uint(mx), false, false); mx = fmaxf(__uint_as_float(rr[0]), __uint_as_float(rr[1])); }
                    if (lane == 0) atomicMax(KN + bh, __float_as_uint(mx)); }
                kn_done = 1; ph = 9;
            } else {
                attn_phase<1>((char*)lds, vcu, G, (const att::bf16*)QKVG, (att::bf16*)OG, (const float*)(ws + WS_CUM), (const float*)(ws + WS_KN), 2 * DI, 0, DI, 3 * DI, (unsigned*)(ws + WS_QCTR) + 512 * (ph == 14), (volatile LAS unsigned*)(ldsl + XB_LDS_OFF) + 8);
            }
        } else if (ph == 3 || ph == 7 || ph == 11 || ph == 15) {
            const bf16r* Bt = (ph == 3) ? (const bf16r*)(ws + WS_WA_OUT) : (ph == 7) ? (const bf16r*)(ws + WS_WA_OUT) + (size_t)DM * DI : (ph == 11) ? (const bf16r*)(ws + WS_WB_OUT) : (const bf16r*)(ws + WS_WB_OUT) + (size_t)DM * DI;
            pg8::Gemm g{OG, Bt, M, DM, DI}; pg8::StaticOrder S; S.init(M, DM, G, bx);
            pg8::EpiRes E{ph == 3 ? args.in[0] : out, out, DM};
            pg8::gemm_phase<pg8::EpiRes, pg8::StaticOrder, PG8_ALIGN, PG8_SP2>(ldsl, g, S, E);
        } else if (ph == 4 || ph == 12) {
            for (int m = gw; m < M; m += NGW) rms_row_to_bf16<false>(out + (size_t)m * DM, XN + (size_t)m * DM, ldsl, lane);
        } else if (ph == 8) {
            const bf16r* FWT = (const bf16r*)(ws + WS_FWT); float* LOGF = (float*)(ws + WS_LOGF); const float* f_b = args.in[8];
#pragma unroll 1
            for (int grp = vcu; grp < M / 32; grp += G) {
#pragma unroll 1
                for (int i = 0; i < 4; ++i) { const int rl = wave * 4 + i; const int m = grp * 32 + rl;
                    rms_row_to_bf16<true>(out + (size_t)m * DM, XN + (size_t)m * DM, ldsl + rl * XN_LDS_PITCH, lane); }
                LDS_WAIT(); __syncthreads();
                const int r32 = lane & 31, hi5 = lane >> 5;
                f32x16 acc = {};
#pragma unroll
                for (int i = 0; i < 16; ++i) { const int k = wave * 256 + i * 16 + hi5 * 8;
                    const bf16x8 a = *(const LAS bf16x8*)(ldsl + r32 * XN_LDS_PITCH + k * 2);
                    const bf16x8 b = *(const GAS bf16x8*)(FWT + (size_t)r32 * DM + k);
                    acc = __builtin_amdgcn_mfma_f32_32x32x16_bf16(a, b, acc, 0, 0, 0); }
                __syncthreads();
                LAS float* red = (LAS float*)ldsl;
#pragma unroll
                for (int r = 0; r < 16; ++r) red[(wave * 32 + att::crow(r, hi5)) * 33 + r32] = acc[r];
                LDS_WAIT(); __syncthreads();
#pragma unroll
                for (int e = 0; e < 2; ++e) { const int idx = tid * 2 + e, row = idx >> 5, head = idx & 31; float v = ((const GAS float*)f_b)[head];
#pragma unroll
                    for (int w = 0; w < 8; ++w) v += red[(w * 32 + row) * 33 + head];
                    const float ls = fminf(v, 0.f) - log1pf(expf(-fabsf(v)));
                    const int m = grp * 32 + row, b = m / SEQ, s = m % SEQ;
                    ((GAS float*)LOGF)[((size_t)(b * NH + head)) * SEQ + s] = ls; }
                __syncthreads();
            }
        } else {
            for (int m = gw; m < M; m += NGW) rms_row_final(out + (size_t)m * DM, args.in[12], lane);
        }
        if (ph + 1 < args.ph_hi) {
            if (ph == 0) grid.sync();
            else { XcdBarrier xb; xb.bar = (unsigned*)(args.ws + WS_CTL); xb.x = xb_xcc_id(); xb.st = (volatile LAS unsigned*)(ldsl + XB_LDS_OFF); xcd_barrier(xb); }
        }
    }
}

extern "C" void kernel_launch(void* const* d_in, const int* in_sizes, int n_in, void* d_out, int out_size, void* d_ws, size_t ws_size, hipStream_t stream) {
    static int grid = 0;
    if (grid == 0) {
        if (n_in != 13 || in_sizes[0] != M * DM || out_size != M * DM || ws_size < WS_END) { fprintf(stderr, "kernel_launch: shape mismatch n_in %d in0 %d out %d ws %zu\n", n_in, n_in > 0 ? in_sizes[0] : -1, out_size, ws_size); grid = -1; return; }
        int dev = 0, cus = 0, per_cu = 0;
        (void)hipGetDevice(&dev); (void)hipDeviceGetAttribute(&cus, hipDeviceAttributeMultiprocessorCount, dev);
        if (hipFuncSetAttribute((const void*)yoco_fwd, hipFuncAttributeMaxDynamicSharedMemorySize, LDS_BYTES) != hipSuccess) { fprintf(stderr, "kernel_launch: hipFuncSetAttribute failed\n"); grid = -1; return; }
        if (hipOccupancyMaxActiveBlocksPerMultiprocessor(&per_cu, (const void*)yoco_fwd, NTHREADS, LDS_BYTES) != hipSuccess || per_cu < 1) { fprintf(stderr, "kernel_launch: occupancy query says %d\n", per_cu); per_cu = 1; }
        (void)hipGetLastError();
        if (cus <= 0) cus = 256;
        grid = cus;
    }
    if (grid < 0) return;
    if (hipMemsetAsync((char*)d_ws + WS_CTL, 0, CTL_BYTES, stream) != hipSuccess) { fprintf(stderr, "kernel_launch: memset of the barrier words failed\n"); return; }
    Args a{};
    for (int i = 0; i < 13; ++i) a.in[i] = (const float*)d_in[i];
    a.out = (float*)d_out; a.ws = (unsigned char*)d_ws;
    a.ph_lo = 0; a.ph_hi = N_PHASES;
    void* kargs[] = {&a};
    hipError_t e = hipLaunchCooperativeKernel((const void*)yoco_fwd, dim3(grid), dim3(NTHREADS), kargs, LDS_BYTES, stream);
    if (e != hipSuccess) fprintf(stderr, "kernel_launch: cooperative launch failed: %s (grid %d)\n", hipGetErrorString(e), grid);
}
```
